# Optimizing an MI355X kernel written in HIP

```python
import jax, jax.numpy as jnp
from jax import lax
import numpy as np

D_MODEL = 2048
BATCH = 2
SEQ = 8192
DEPTH = 2

GRID_W = 64
CTX_LEN = 256
F_WIDTH = D_MODEL // 2
F_GROUPS = 4
F_GW = F_WIDTH // F_GROUPS
M_HEADS = 8
M_WIDTH = D_MODEL // 2
M_DV = M_WIDTH // M_HEADS
M_DK = M_DV // 2
QK_WIDTH = 2 * M_HEADS * M_DK
N_GATES = 4 * M_HEADS
PROJ_WIDTH = F_WIDTH + QK_WIDTH + M_WIDTH + M_WIDTH + N_GATES
MIX_WIDTH = F_WIDTH + M_WIDTH
CHUNK = 64
CONV_K = 3
N_KEYS = 128
N_EXPERTS = N_KEYS * N_KEYS
PEER_HEADS = 8
PEER_TOPK = 16
PEER_QDIM = 256
PEER_BLOCK = 128
N_MOD = 6
EPS = 1e-6

kernel_name = 'hybrid_fnet_mlstm_peer_dit'


def rmsnorm(x, g):
    xf = x.astype(jnp.float32)
    y = xf * lax.rsqrt(jnp.mean(xf * xf, axis=-1, keepdims=True) + EPS)
    return (y * g.astype(jnp.float32)).astype(x.dtype)


def modulate(h, shift, scale):
    return h * (1 + scale) + shift


def split_proj(p, b_gate):
    o1 = F_WIDTH
    o2 = o1 + QK_WIDTH
    o3 = o2 + M_WIDTH
    o4 = o3 + M_WIDTH
    return p[..., :o1], p[..., o1:o2], p[..., o2:o3], p[..., o3:o4], p[..., o4:] + b_gate


def fourier_mix(u, g):
    B_, T, _ = u.shape
    uf = u.astype(jnp.float32).reshape(B_, T, F_GROUPS, F_GW)
    y = jnp.fft.fft2(uf, axes=(1, 3), norm='ortho').real
    return rmsnorm(y, g.reshape(F_GROUPS, F_GW)).reshape(B_, T, F_WIDTH).astype(u.dtype)


def conv_latent(u, w, rows):
    B_ = u.shape[0]
    img = u.reshape(B_, rows, GRID_W, QK_WIDTH)
    y = lax.conv_general_dilated(img, w[:, :, None, :].astype(u.dtype), (1, 1), 'SAME',
                                 dimension_numbers=('NHWC', 'HWIO', 'NHWC'),
                                 feature_group_count=QK_WIDTH)
    return y.reshape(u.shape)


def conv_context(u, w):
    y = lax.conv_general_dilated(u, w[CONV_K // 2][:, None, :].astype(u.dtype), (1,), 'SAME',
                                 dimension_numbers=('NWC', 'WIO', 'NWC'),
                                 feature_group_count=QK_WIDTH)
    return y


def mlstm_chunkwise(q, k, v, ig, lf, state):
    B_, H_, T, dk = q.shape
    dv = v.shape[-1]
    nc = T // CHUNK
    q = q.reshape(B_, H_, nc, CHUNK, dk)
    k = k.reshape(B_, H_, nc, CHUNK, dk)
    v = v.reshape(B_, H_, nc, CHUNK, dv)
    ig = ig.reshape(B_, H_, nc, CHUNK)
    lf = lf.reshape(B_, H_, nc, CHUNK)
    b = jnp.cumsum(lf, axis=-1)
    b_end = b[..., -1]
    a = b_end[..., None] - b + ig
    m_loc = jnp.max(a, axis=-1)
    kw = k * jnp.exp(a - m_loc[..., None])[..., None]
    C_chunk = jnp.einsum('bhcsk,bhcsv->bhckv', kw, v)
    n_chunk = jnp.sum(kw, axis=3)

    def step(carry, inp):
        C, n, m = carry
        Cc, ncnk, mc, be = inp
        m_new = jnp.maximum(be + m, mc)
        f_old = jnp.exp(be + m - m_new)
        f_new = jnp.exp(mc - m_new)
        C_new = f_old[..., None, None] * C + f_new[..., None, None] * Cc
        n_new = f_old[..., None] * n + f_new[..., None] * ncnk
        return (C_new, n_new, m_new), (C, n, m)

    xs = (jnp.moveaxis(C_chunk, 2, 0), jnp.moveaxis(n_chunk, 2, 0),
          jnp.moveaxis(m_loc, 2, 0), jnp.moveaxis(b_end, 2, 0))
    final, (C_prev, n_prev, m_prev) = lax.scan(step, state, xs)
    C_prev = jnp.moveaxis(C_prev, 0, 2)
    n_prev = jnp.moveaxis(n_prev, 0, 2)
    m_prev = jnp.moveaxis(m_prev, 0, 2)

    tri = jnp.tril(jnp.ones((CHUNK, CHUNK), dtype=bool))
    D = jnp.where(tri, b[..., :, None] - b[..., None, :] + ig[..., None, :], -jnp.inf)
    g = b + m_prev[..., None]
    m_j = jnp.maximum(g, jnp.max(D, axis=-1))
    S = jnp.einsum('bhcjk,bhcsk->bhcjs', q, k) * jnp.exp(D - m_j[..., None])
    inter = jnp.exp(g - m_j)
    num = inter[..., None] * jnp.einsum('bhcjk,bhckv->bhcjv', q, C_prev) + jnp.einsum('bhcjs,bhcsv->bhcjv', S, v)
    den = inter * jnp.einsum('bhcjk,bhck->bhcj', q, n_prev) + jnp.sum(S, axis=-1)
    h = num / jnp.maximum(jnp.abs(den), jnp.exp(-m_j))[..., None]
    return h.reshape(B_, H_, T, dv), final


def mlstm_mix(qk, v, o, gates, g, states):
    B_, T, _ = qk.shape
    heads = lambda t, d: t.astype(jnp.float32).reshape(B_, T, M_HEADS, d).transpose(0, 2, 1, 3)
    q = heads(qk[..., :QK_WIDTH // 2], M_DK)
    k = heads(qk[..., QK_WIDTH // 2:], M_DK) * (M_DK ** -0.5)
    vh = heads(v, M_DV)
    gt = gates.astype(jnp.float32).reshape(B_, T, 4, M_HEADS).transpose(2, 0, 3, 1)
    h_f, st_f = mlstm_chunkwise(q, k, vh, gt[0], jax.nn.log_sigmoid(gt[1]), states[0])
    rev = lambda t: jnp.flip(t, axis=2)
    h_b, st_b = mlstm_chunkwise(rev(q), rev(k), rev(vh), rev(gt[2]),
                                rev(jax.nn.log_sigmoid(gt[3])), states[1])
    h = (h_f + rev(h_b)).transpose(0, 2, 1, 3)
    h = rmsnorm(h, g.reshape(M_HEADS, M_DV)).reshape(B_, T, M_WIDTH)
    y = h * jax.nn.sigmoid(o.astype(jnp.float32))
    return y.astype(v.dtype), (st_f, st_b)


def peer(h, w_query, sub_keys, expert_u, expert_v):
    shape = h.shape
    blocks = h.reshape(-1, PEER_BLOCK, D_MODEL)

    def block(xb):
        q = (xb @ w_query).reshape(PEER_BLOCK, PEER_HEADS, 2, PEER_QDIM // 2)
        s = jnp.einsum('thpd,hpnd->thpn', q, sub_keys)
        sv, si = lax.top_k(s, PEER_TOPK)
        cand = (sv[:, :, 0, :, None] + sv[:, :, 1, None, :]).reshape(PEER_BLOCK, PEER_HEADS, PEER_TOPK * PEER_TOPK)
        cidx = (si[:, :, 0, :, None] * N_KEYS + si[:, :, 1, None, :]).reshape(PEER_BLOCK, PEER_HEADS, PEER_TOPK * PEER_TOPK)
        top_s, pos = lax.top_k(cand, PEER_TOPK)
        idx = jnp.take_along_axis(cidx, pos, axis=-1)
        gate = jax.nn.softmax(top_s.astype(jnp.float32), axis=-1)
        act = jax.nn.gelu(jnp.einsum('thkd,td->thk', expert_u[idx], xb).astype(jnp.float32))
        return jnp.einsum('thk,thkd->td', (gate * act).astype(xb.dtype), expert_v[idx])

    return lax.map(block, blocks).reshape(shape)


def setup_inputs(seed: int = 0) -> dict:
    key = jax.random.key(seed)
    ks = jax.random.split(key, 20)
    nrm = lambda k, shape, s: jax.random.normal(k, shape, jnp.float32) * s
    L, D = DEPTH, D_MODEL
    f_bias = jnp.linspace(3.0, 6.0, M_HEADS, dtype=jnp.float32)
    i_bias = jnp.zeros((M_HEADS,), jnp.float32)
    gate_base = jnp.concatenate([i_bias, f_bias, i_bias, f_bias])
    return {
        'x': nrm(ks[0], (BATCH, SEQ, D), 1.0),
        'c': nrm(ks[1], (BATCH, D), 1.0),
        'ctx': nrm(ks[2], (BATCH, CTX_LEN, D), 1.0),
        'c_ctx': nrm(ks[3], (D,), 1.0),
        'w_mod': nrm(ks[4], (L, D, N_MOD * D), 0.5 * D ** -0.5),
        'b_mod': nrm(ks[5], (L, N_MOD * D), 0.02),
        'g_norm_mix': 1.0 + nrm(ks[6], (L, D), 0.02),
        'g_norm_ffn': 1.0 + nrm(ks[7], (L, D), 0.02),
        'w_in': nrm(ks[8], (L, D, PROJ_WIDTH), D ** -0.5),
        'b_gate': gate_base + nrm(ks[9], (L, N_GATES), 0.1),
        'conv_qk': nrm(ks[10], (L, CONV_K, CONV_K, QK_WIDTH), 1.0 / CONV_K),
        'g_fourier': 1.0 + nrm(ks[11], (L, F_WIDTH), 0.02),
        'g_mlstm': 1.0 + nrm(ks[12], (L, M_WIDTH), 0.02),
        'w_out': nrm(ks[13], (L, MIX_WIDTH, D), MIX_WIDTH ** -0.5),
        'w_query': nrm(ks[14], (L, D, PEER_HEADS * PEER_QDIM), D ** -0.5),
        'sub_keys': nrm(ks[15], (L, PEER_HEADS, 2, N_KEYS, PEER_QDIM // 2), (PEER_QDIM // 2) ** -0.5),
        'expert_u': nrm(ks[16], (L, N_EXPERTS, D), D ** -0.5),
        'expert_v': nrm(ks[17], (L, N_EXPERTS, D), 1.0),
        'g_final': 1.0 + nrm(ks[18], (D,), 0.02),
    }


def reference(x, c, ctx, c_ctx, w_mod, b_mod, g_norm_mix, g_norm_ffn, w_in, b_gate, conv_qk,
              g_fourier, g_mlstm, w_out, w_query, sub_keys, expert_u, expert_v, g_final):
    B_, T, _ = x.shape
    rows = T // GRID_W
    zero = (jnp.zeros((B_, M_HEADS, M_DK, M_DV), jnp.float32),
            jnp.zeros((B_, M_HEADS, M_DK), jnp.float32),
            jnp.zeros((B_, M_HEADS), jnp.float32))
    for l in range(DEPTH):
        last = l == DEPTH - 1
        mod = jax.nn.silu(c) @ w_mod[l] + b_mod[l]
        mod_c = jax.nn.silu(c_ctx) @ w_mod[l] + b_mod[l]
        sh1, sc1, ga1, sh2, sc2, ga2 = jnp.split(mod[:, None, :], N_MOD, axis=-1)
        csh1, csc1, cga1, csh2, csc2, cga2 = jnp.split(mod_c, N_MOD)

        pc = modulate(rmsnorm(ctx, g_norm_mix[l]), csh1, csc1) @ w_in[l]
        four_c, qk_c, v_c, o_c, gates_c = split_proj(pc, b_gate[l])
        qk_c = jax.nn.silu(conv_context(qk_c, conv_qk[l]))
        y_mc, ctx_states = mlstm_mix(qk_c, v_c, o_c, gates_c, g_mlstm[l], (zero, zero))

        p = modulate(rmsnorm(x, g_norm_mix[l]), sh1, sc1) @ w_in[l]
        four, qk, v, o, gates = split_proj(p, b_gate[l])
        qk = jax.nn.silu(conv_latent(qk, conv_qk[l], rows))
        y_m, _ = mlstm_mix(qk, v, o, gates, g_mlstm[l], ctx_states)
        y = jnp.concatenate([fourier_mix(four, g_fourier[l]), y_m], axis=-1) @ w_out[l]
        x = x + ga1 * y
        h2 = modulate(rmsnorm(x, g_norm_ffn[l]), sh2, sc2)
        x = x + ga2 * peer(h2, w_query[l], sub_keys[l], expert_u[l], expert_v[l])

        if not last:
            yc = jnp.concatenate([fourier_mix(four_c, g_fourier[l]), y_mc], axis=-1) @ w_out[l]
            ctx = ctx + cga1 * yc
            hc2 = modulate(rmsnorm(ctx, g_norm_ffn[l]), csh2, csc2)
            ctx = ctx + cga2 * peer(hc2, w_query[l], sub_keys[l], expert_u[l], expert_v[l])
    return rmsnorm(x, g_final)
```

```cpp
#ifndef CPU_EMU
#include <hip/hip_runtime.h>
#include <hip/hip_cooperative_groups.h>
#include <cstdio>
#include <cstdint>
#endif
#include <cmath>

#ifndef SEQ_LEN
#define SEQ_LEN 8192
#endif
#ifndef CTX_LEN_
#define CTX_LEN_ 256
#endif
#ifndef FN1
#define FN1 64
#endif

namespace mk {
typedef unsigned short u16;
typedef unsigned int u32;
#ifndef CPU_EMU
typedef short bf16x8 __attribute__((ext_vector_type(8)));
typedef float f32x4 __attribute__((ext_vector_type(4)));
#endif
typedef unsigned u32x4 __attribute__((ext_vector_type(4)));
typedef unsigned u32x2 __attribute__((ext_vector_type(2)));

constexpr int D = 2048, NB = 2, T = SEQ_LEN, TC = CTX_LEN_;
constexpr int ML = NB * T, MC = NB * TC, M = ML + MC;
constexpr int FGW = 256, MH = 8, DV = 128, DK = 64, NG = 32, PWP = 4352, PLD = 4096;
constexpr int NCL = T / 64, NCC = TC / 64, NCT = NCL + NCC;
constexpr int NK = 128, PH = 8, PK = 16;
constexpr int N1L = FN1, N2L = T / FN1, N1C = 16, N2C = TC / 16;
constexpr float EPS = 1e-6f;
constexpr int NLAYER = 2;
static_assert(M % 256 == 0 && ML % 256 == 0 && T % 64 == 0 && TC % 64 == 0, "row tiling");
static_assert(N1L * N2L == T && N1C * N2C == TC && N1L % 16 == 0 && N2L % 16 == 0 && N2C % 16 == 0, "dft factorisation");

constexpr size_t al(size_t x) { return (x + 4095) & ~(size_t)4095; }
constexpr size_t WS_CTL = 0, CTL_BYTES = 1u << 20;
constexpr size_t WS_MOD = WS_CTL + CTL_BYTES;
constexpr size_t WS_MODP = WS_MOD + al((size_t)2 * 3 * 12288 * 4);
constexpr size_t WS_WIN = WS_MODP + al((size_t)32 * 2 * 3 * 12288 * 4);
constexpr size_t WS_WOUT = WS_WIN + al((size_t)2 * PWP * D * 2);
constexpr size_t WS_WQ = WS_WOUT + al((size_t)2 * D * D * 2);
constexpr size_t WS_KEYS = WS_WQ + al((size_t)2 * D * D * 2);
constexpr int EROW = D * 6 / 8;
constexpr size_t WS_EU = WS_KEYS + al((size_t)2 * 8 * 2 * NK * 128 * 2);
constexpr size_t WS_EV = WS_EU + al((size_t)2 * NK * NK * EROW);
constexpr size_t WS_USC = WS_EV + al((size_t)2 * NK * NK * EROW);
constexpr size_t WS_VSC = WS_USC + al((size_t)2 * NK * NK * 4);
constexpr size_t WS_XS = WS_VSC + al((size_t)2 * NK * NK * 4);
constexpr size_t WS_H = WS_XS + al((size_t)M * D * 4);
constexpr size_t WS_P = WS_H + al((size_t)M * D * 2);
constexpr size_t WS_GATES = WS_P + al((size_t)M * PLD * 2);
constexpr size_t WS_QKC = WS_GATES + al((size_t)M * NG * 4);
constexpr size_t WS_Y = WS_QKC + al((size_t)M * 1024 * 2);
constexpr size_t WS_CCH = WS_Y + al((size_t)M * D * 2);
constexpr size_t WS_CPV = WS_CCH + al((size_t)2 * 16 * NCT * 8192 * 2);
constexpr size_t WS_NCH = WS_CPV + al((size_t)2 * 16 * NCT * 8192 * 2);
constexpr size_t WS_NPV = WS_NCH + al((size_t)2 * 16 * NCT * 64 * 4);
constexpr size_t WS_MLOC = WS_NPV + al((size_t)2 * 16 * NCT * 64 * 4);
constexpr size_t WS_BEND = WS_MLOC + al((size_t)2 * 16 * NCT * 4);
constexpr size_t WS_MPV = WS_BEND + al((size_t)2 * 16 * NCT * 4);
constexpr size_t WS_GAL = WS_MPV + al((size_t)2 * 16 * NCT * 4);
constexpr size_t WS_GAC = WS_GAL + al((size_t)NB * 4 * T * 288 * 2);
constexpr size_t WS_WR = WS_GAC + al((size_t)NB * 4 * TC * 288 * 2);
constexpr size_t WS_IDX = WS_WR + al((size_t)M * 576 * 4);
constexpr size_t WS_GW = WS_IDX + al((size_t)M * 128 * 4);
constexpr size_t WS_MQ = WS_GW + al((size_t)M * 128 * 4);
constexpr size_t WS_END = WS_MQ + al((size_t)256 * 256 * 2);
constexpr size_t WS_QP = WS_P;
static_assert(SEQ_LEN != 8192 || WS_END <= (size_t)1073741824, "workspace map exceeds 1 GiB");

__device__ __forceinline__ float bf2f(u32 h) { u32 u = h << 16; float f; __builtin_memcpy(&f, &u, 4); return f; }
#ifdef CPU_EMU
__device__ __forceinline__ u32 f2bf(float f) { u32 u; __builtin_memcpy(&u, &f, 4); return (u + 0x7fffu + ((u >> 16) & 1u)) >> 16; }
#else
__device__ __forceinline__ u32 f2bf(float f) { return (u32)__builtin_bit_cast(unsigned short, (__bf16)f); }
#endif
#ifdef CPU_EMU
__device__ __forceinline__ u32 pk2(float lo, float hi) { return f2bf(lo) | (f2bf(hi) << 16); }
#else
typedef __bf16 bf16x2_t_ __attribute__((ext_vector_type(2)));
typedef float f32x2_t_ __attribute__((ext_vector_type(2)));
__device__ __forceinline__ u32 pk2(float lo, float hi) { return __builtin_bit_cast(u32, __builtin_convertvector((f32x2_t_){lo, hi}, bf16x2_t_)); }
#endif
__device__ __forceinline__ float lo16(u32 w) { u32 u = w << 16; float f; __builtin_memcpy(&f, &u, 4); return f; }
__device__ __forceinline__ float hi16(u32 w) { u32 u = w & 0xffff0000u; float f; __builtin_memcpy(&f, &u, 4); return f; }
__device__ __forceinline__ u32 fbits(float f) { u32 u; __builtin_memcpy(&u, &f, 4); return u; }
__device__ __forceinline__ float bitsf(u32 u) { float f; __builtin_memcpy(&f, &u, 4); return f; }
#ifdef CPU_EMU
__device__ __forceinline__ float fexp(float x) { return expf(x); }
__device__ __forceinline__ float frcp(float x) { return 1.0f / x; }
__device__ __forceinline__ float frsq(float x) { return 1.0f / sqrtf(x); }
#else
__device__ __forceinline__ float fexp(float x) { return __builtin_amdgcn_exp2f(x * 1.4426950408889634f); }
__device__ __forceinline__ float frcp(float x) { return __builtin_amdgcn_rcpf(x); }
__device__ __forceinline__ float frsq(float x) { return __builtin_amdgcn_rsqf(x); }
#endif
#ifdef CPU_EMU
__device__ __forceinline__ float cos_rev(float x) { return cosf(6.283185307179586f * x); }
__device__ __forceinline__ float sin_rev(float x) { return sinf(6.283185307179586f * x); }
#else
__device__ __forceinline__ float cos_rev(float x) { return __builtin_amdgcn_cosf(x); }
__device__ __forceinline__ float sin_rev(float x) { return __builtin_amdgcn_sinf(x); }
#endif
__device__ __forceinline__ float sigmoidf_(float x) { return frcp(1.0f + fexp(-x)); }
__device__ __forceinline__ float siluf_(float x) { return x * frcp(1.0f + fexp(-x)); }
__device__ __forceinline__ float logsigf_(float x) { return x < 0.f ? x - log1pf(expf(x)) : -log1pf(expf(-x)); }
__device__ __forceinline__ float geluf_(float x) { return 0.5f * x * (1.0f + tanhf(0.7978845608028654f * (x + 0.044715f * x * x * x))); }
typedef unsigned u32x6 __attribute__((ext_vector_type(6)));
__device__ __forceinline__ u32 f2e2m3(float x) {
    const u32 sgn = (fbits(x) >> 31) << 5; const float a = fabsf(x); u32 code;
    if (a >= 7.5f) code = 31u;
    else if (a < 2.0f) code = (u32)(int)rintf(a * 8.0f);
    else if (a < 4.0f) code = (u32)(int)rintf(a * 4.0f) + 8u;
    else { code = (u32)(int)rintf(a * 2.0f) + 16u; if (code > 31u) code = 31u; }
    return sgn | code;
}
#ifndef CPU_EMU
typedef float f32x16_ __attribute__((ext_vector_type(16)));
__device__ __forceinline__ u32x6 fp6_enc32(const float* v) {
    f32x16_ x, y;
#pragma unroll
    for (int i = 0; i < 16; ++i) { x[i] = v[2 * i]; y[i] = v[2 * i + 1]; }
    return __builtin_amdgcn_cvt_scalef32_2xpk16_fp6_f32(x, y, 1.0f);
}
__device__ __forceinline__ u32x6 fp6_enc32_sw(const float* v) {
#else
__device__ __forceinline__ u32x6 fp6_enc32(const float* v) {
#endif
    u32 w[6] = {0u, 0u, 0u, 0u, 0u, 0u};
#pragma unroll
    for (int i = 0; i < 32; ++i) { const u32 cd = f2e2m3(v[i]); const int bit = 6 * i, d = bit >> 5, sh = bit & 31; w[d] |= cd << sh; if (sh > 26) w[d + 1] |= cd >> (32 - sh); }
    return (u32x6){w[0], w[1], w[2], w[3], w[4], w[5]};
}
#ifdef CPU_EMU
__device__ __forceinline__ float e2m32f(u32 c) { const u32 e = (c >> 3) & 3u, m = c & 7u; const float v = e == 0 ? (float)m * 0.125f : (1.0f + (float)m * 0.125f) * (float)(1u << (e - 1)); return (c & 32u) ? -v : v; }
__device__ __forceinline__ void fp6_dec32(const u32x6& p, float* o) {
    const u32 w[6] = {p[0], p[1], p[2], p[3], p[4], p[5]};
    for (int i = 0; i < 32; ++i) { const int bit = 6 * i, d = bit >> 5, sh = bit & 31; u32 c = w[d] >> sh; if (sh > 26) c |= w[d + 1] << (32 - sh); o[i] = e2m32f(c & 63u); }
}
#else
typedef float f32x32_ __attribute__((ext_vector_type(32)));
__device__ __forceinline__ void fp6_dec32(const u32x6& p, float* o) {
    const f32x32_ f = __builtin_amdgcn_cvt_scalef32_pk32_f32_fp6(p, 1.0f);
#pragma unroll
    for (int i = 0; i < 32; ++i) o[i] = f[i];
}
#endif
#ifdef CPU_EMU
__device__ __forceinline__ void fp6_dec32_bf16(const u32x6& p, u32* o) { float f[32]; fp6_dec32(p, f); for (int i = 0; i < 16; ++i) o[i] = pk2(f[2 * i], f[2 * i + 1]); }
#else
typedef __bf16 bf16x32_ __attribute__((ext_vector_type(32)));
typedef unsigned u32x16_ __attribute__((ext_vector_type(16)));
__device__ __forceinline__ void fp6_dec32_bf16(const u32x6& p, u32* o) {
    const u32x16_ w = __builtin_bit_cast(u32x16_, __builtin_amdgcn_cvt_scalef32_pk32_bf16_fp6(p, 1.0f));
#pragma unroll
    for (int i = 0; i < 16; ++i) o[i] = w[i];
}
#endif
#ifdef CPU_EMU
__device__ __forceinline__ float lane_xor1(float v) { return __shfl_xor(v, 1); }
__device__ __forceinline__ float lane_xor2(float v) { return __shfl_xor(v, 2); }
__device__ __forceinline__ float sum_lanebits_2_5(float v) { v += __shfl_xor(v, 4); v += __shfl_xor(v, 8); v += __shfl_xor(v, 16); v += __shfl_xor(v, 32); return v; }
__device__ __forceinline__ float max_lanebits_2_5(float v) { v = fmaxf(v, __shfl_xor(v, 4)); v = fmaxf(v, __shfl_xor(v, 8)); v = fmaxf(v, __shfl_xor(v, 16)); v = fmaxf(v, __shfl_xor(v, 32)); return v; }
__device__ __forceinline__ float bcast_lane_f(float v, int l) { return __shfl(v, l); }
__device__ __forceinline__ int bcast_lane_i(int v, int l) { return __shfl(v, l); }
#else
typedef unsigned u32x2_ __attribute__((ext_vector_type(2)));
#define DPP_F(v, ctrl) __builtin_bit_cast(float, __builtin_amdgcn_mov_dpp(__builtin_bit_cast(int, (v)), (ctrl), 0xF, 0xF, true))
__device__ __forceinline__ float lane_xor1(float v) { return DPP_F(v, 0xB1); }
__device__ __forceinline__ float lane_xor2(float v) { return DPP_F(v, 0x4E); }
__device__ __forceinline__ float sum_lanebits_2_5(float v) {
    v += DPP_F(v, 0x128);
    v += DPP_F(v, 0x124);
    v += __shfl_xor(v, 16); v += __shfl_xor(v, 32);
    return v;
}
__device__ __forceinline__ float max_lanebits_2_5(float v) {
    v = fmaxf(v, DPP_F(v, 0x128)); v = fmaxf(v, DPP_F(v, 0x124));
    v = fmaxf(v, __shfl_xor(v, 16)); v = fmaxf(v, __shfl_xor(v, 32));
    return v;
}
__device__ __forceinline__ float bcast_lane_f(float v, int l) { return __builtin_bit_cast(float, __builtin_amdgcn_readlane(__builtin_bit_cast(int, v), l)); }
__device__ __forceinline__ int bcast_lane_i(int v, int l) { return __builtin_amdgcn_readlane(v, l); }
#endif
__device__ __forceinline__ float wave_sum(float v) { v += lane_xor1(v); v += lane_xor2(v); return sum_lanebits_2_5(v); }
__device__ __forceinline__ float wave_max(float v) { v = fmaxf(v, lane_xor1(v)); v = fmaxf(v, lane_xor2(v)); return max_lanebits_2_5(v); }
__device__ __forceinline__ float gelu_fast(float x) { const float u2 = 1.5957691216057308f * (x + 0.044715f * x * x * x); return x / (1.0f + __expf(-u2)); }
__device__ __forceinline__ float prefix_sum_incl(float v, int lane) {
#pragma unroll
    for (int o = 1; o < 64; o <<= 1) { float t = __shfl_up(v, o); if (lane >= o) v += t; }
    return v;
}
__device__ __forceinline__ float suffix_sum_incl(float v, int lane) {
#pragma unroll
    for (int o = 1; o < 64; o <<= 1) { float t = __shfl_down(v, o); if (lane + o < 64) v += t; }
    return v;
}
__device__ __forceinline__ float prefix_max_incl(float v, int lane) {
#pragma unroll
    for (int o = 1; o < 64; o <<= 1) { float t = __shfl_up(v, o); if (lane >= o) v = fmaxf(v, t); }
    return v;
}
__device__ __forceinline__ float suffix_max_incl(float v, int lane) {
#pragma unroll
    for (int o = 1; o < 64; o <<= 1) { float t = __shfl_down(v, o); if (lane + o < 64) v = fmaxf(v, t); }
    return v;
}
__device__ __forceinline__ bf16x8 ld_frag(const u16* tile, int row0, int k0, int LD, int lane) {
    return *(const bf16x8*)(tile + (row0 + (lane & 15)) * LD + k0 + 8 * (lane >> 4));
}
#define MFMA_T(bf, af, acc) __builtin_amdgcn_mfma_f32_16x16x32_bf16((bf), (af), (acc), 0, 0, 0)
__device__ __forceinline__ bf16x8 mk8(u32 a, u32 b, u32 c, u32 d) { return __builtin_bit_cast(bf16x8, (u32x4){a, b, c, d}); }
#ifdef CPU_EMU
#define WAVE_SYNC() emu_wave_barrier()
#else
#define WAVE_SYNC() asm volatile("s_waitcnt lgkmcnt(0)" ::: "memory")
#endif

struct KArgs { const float* in[19]; float* out; unsigned char* ws; int ph_lo, ph_hi; };
struct Ctx {
    unsigned char* lds; int tid, lane, wave, bid, G, gw, ngw;
};

namespace pg8 {
constexpr int BM = 256, BK = 64, HALF = 128, HTB = HALF * BK * 2, STAGE_BYTES = 8 * HTB, NXCD = 8, WGM = 8;
struct Unit { int pm, pn; };
struct Gemm { const u16* A; const u16* Bt; int M, N, K; };
struct StaticOrder {
    int nM, nN, nwg, G, c;
    __host__ __device__ void init(int M_, int N_, int G_, int c_) { nM = M_ / BM; nN = N_ / BM; nwg = nM * nN; G = G_; c = c_; }
    __host__ __device__ bool next(int i, Unit& u) const {
        const long L = (long)i * G + c; if (L >= nwg) return false;
        int wgid = (int)L; { const int q = nwg / NXCD, r = nwg % NXCD, xcd = wgid % NXCD, off = wgid / NXCD; wgid = (xcd < r ? xcd * (q + 1) : r * (q + 1) + (xcd - r) * q) + off; }
        const int nig = WGM * nN, gid = wgid / nig, fm = gid * WGM, gsz = (nM - fm) < WGM ? (nM - fm) : WGM;
        u.pm = fm + ((wgid % nig) % gsz); u.pn = (wgid % nig) / gsz; return true;
    }
    __device__ __forceinline__ void a_ready(const Unit&) const {}
    __device__ __forceinline__ void done(const Unit&) const {}
};
#ifndef CPU_EMU
#define PG8_LAS __attribute__((address_space(3)))
__host__ __device__ __forceinline__ int lds_byte(int r, int c) { const int st = (r >> 4) * 2 + (c >> 5), rr = r & 15, cc = c & 31, ob = rr * 64 + cc * 2; return st * 1024 + (ob ^ (((ob >> 9) & 1) << 5)); }
__host__ __device__ __forceinline__ void stage_rc(int b, int& R, int& C) { const int st = b / 1024, sb = b % 1024, swz = sb ^ (((sb >> 9) & 1) << 5); R = (st >> 1) * 16 + swz / 64; C = (st & 1) * 32 + (swz % 64) / 2; }
__host__ __device__ __forceinline__ int perm32(int rho) { const int n = rho >> 4, i = rho & 15; return 8 * (i >> 2) + 4 * n + (i & 3); }
__device__ __forceinline__ unsigned cvt_pk_bf16(float lo, float hi) { unsigned r; asm volatile("v_cvt_pk_bf16_f32 %0, %1, %2" : "=v"(r) : "v"(lo), "v"(hi)); return r; }

template <class Epi, class Sched, bool ALIGN_EPI = false, bool SP2 = false>
__device__ __forceinline__ void gemm_phase(PG8_LAS unsigned char* lds, const Gemm g, const Sched& S, const Epi& E) {
    const int tid = threadIdx.x, wid = __builtin_amdgcn_readfirstlane(tid >> 6), lane = tid & 63, wr = wid >> 2, wc = wid & 3, fr = lane & 15, fq = lane >> 4;
    const int K = g.K, nt = K / BK;
    unsigned voffA[2], voffB[2];
#pragma unroll
    for (int i = 0; i < 2; ++i) { int R, C; stage_rc(tid * 16 + i * 8192, R, C); const int Rb = Epi::PERM ? ((R & ~31) + perm32(R & 31)) : R;
        voffA[i] = (unsigned)(R * K + C) * 2u; voffB[i] = (unsigned)(Rb * K + C) * 2u; }
    const size_t kstep = (size_t)(BK * 2);
    const size_t hstep = (size_t)HALF * K * 2;
    const size_t tstep = 2 * hstep;
    const unsigned ldsw = (unsigned)wid * 1024u;
    const int aoff = lds_byte(wr * 64 + fr, fq * 8), boff = lds_byte(wc * 32 + fr, fq * 8);
#define PG8_SA(b, h) (((b) * 2 + (h)) * HTB)
#define PG8_SB(b, h) ((4 + (b) * 2 + (h)) * HTB)
#define PG8_STAGE(bufoff, gbase, voff) do { _Pragma("unroll") for (int _i = 0; _i < 2; ++_i) \
        __builtin_amdgcn_global_load_lds((const unsigned*)((const char*)(gbase) + (voff)[_i]), (PG8_LAS unsigned*)(lds + (bufoff) + ldsw + _i * 8192), 16, 0, 0); } while (0)
#define PG8_LDA(dst, b, h) do { _Pragma("unroll") for (int m = 0; m < 4; ++m) _Pragma("unroll") for (int k = 0; k < 2; ++k) dst[m][k] = *(const PG8_LAS bf16x8*)(lds + PG8_SA(b, h) + aoff + m * 2048 + k * 1024); } while (0)
#define PG8_LDB(dst, b, h) do { _Pragma("unroll") for (int n = 0; n < 2; ++n) _Pragma("unroll") for (int k = 0; k < 2; ++k) dst[n][k] = *(const PG8_LAS bf16x8*)(lds + PG8_SB(b, h) + boff + n * 2048 + k * 1024); } while (0)
#define PG8_MMA(ai, bj, At, Bt) do { __builtin_amdgcn_s_setprio(1); _Pragma("unroll") for (int m = 0; m < 4; ++m) _Pragma("unroll") for (int n = 0; n < 2; ++n) _Pragma("unroll") for (int k = 0; k < 2; ++k) \
        acc[ai][bj][m][n] = __builtin_amdgcn_mfma_f32_16x16x32_bf16(Bt[n][k], At[m][k], acc[ai][bj][m][n], 0, 0, 0); __builtin_amdgcn_s_setprio(0); } while (0)
#define PG8_WAIT_V(n) asm volatile("s_waitcnt vmcnt(" #n ")" ::: "memory")
#define PG8_WAIT_L(n) asm volatile("s_waitcnt lgkmcnt(" #n ")" ::: "memory")
#define PG8_BAR __builtin_amdgcn_s_barrier()
#define PG8_SCHED __builtin_amdgcn_sched_barrier(0)
    Unit cur, nxt; int ui = 0;
    if (!S.next(0, cur)) return;
    f32x4 acc[2][2][4][2];
#pragma unroll
    for (int a = 0; a < 2; ++a)
#pragma unroll
        for (int b = 0; b < 2; ++b)
#pragma unroll
            for (int m = 0; m < 4; ++m)
#pragma unroll
                for (int n = 0; n < 2; ++n) acc[a][b][m][n] = (f32x4){0.f, 0.f, 0.f, 0.f};
    bf16x8 At[4][2], B0[2][2], B1[2][2];
    const char* cA = (const char*)g.A + (size_t)cur.pm * tstep; const char* cB = (const char*)g.Bt + (size_t)cur.pn * tstep;
    S.a_ready(cur);
    if constexpr (SP2) {
        PG8_STAGE(PG8_SB(0, 0), cB, voffB); PG8_STAGE(PG8_SB(0, 1), cB + hstep, voffB); PG8_STAGE(PG8_SA(0, 0), cA, voffA); PG8_STAGE(PG8_SA(0, 1), cA + hstep, voffA);
        if (wr == 1) PG8_BAR;
        PG8_WAIT_V(2); PG8_BAR;
        PG8_STAGE(PG8_SB(1, 0), cB + kstep, voffB); PG8_STAGE(PG8_SA(1, 0), cA + kstep, voffA); PG8_STAGE(PG8_SB(1, 1), cB + hstep + kstep, voffB);
        PG8_WAIT_V(6); PG8_BAR;
    } else {
        PG8_STAGE(PG8_SB(0, 0), cB, voffB); PG8_STAGE(PG8_SA(0, 0), cA, voffA); PG8_STAGE(PG8_SB(0, 1), cB + hstep, voffB); PG8_STAGE(PG8_SA(0, 1), cA + hstep, voffA);
        if (wr == 1) PG8_BAR;
        PG8_WAIT_V(4); PG8_BAR;
        PG8_STAGE(PG8_SB(1, 0), cB + kstep, voffB); PG8_STAGE(PG8_SA(1, 0), cA + kstep, voffA); PG8_STAGE(PG8_SB(1, 1), cB + hstep + kstep, voffB);
        PG8_WAIT_V(6); PG8_BAR;
    }
    for (;;) {
        const bool has_next = S.next(ui + 1, nxt);
        const char* nA = has_next ? (const char*)g.A + (size_t)nxt.pm * tstep : cA; const char* nB = has_next ? (const char*)g.Bt + (size_t)nxt.pn * tstep : cB;
        for (int t = 0; t < nt; t += 2) {
            const bool last = (t == nt - 2);
            const char* a1 = cA + (size_t)(t + 1) * kstep;
            const char* a2 = last ? nA : cA + (size_t)(t + 2) * kstep; const char* b2 = last ? nB : cB + (size_t)(t + 2) * kstep;
            const char* a3 = a2 + kstep; const char* b3 = b2 + kstep;
            if (last && has_next) S.a_ready(nxt);
            if constexpr (SP2) {
            PG8_LDB(B0, 0, 0); PG8_LDB(B1, 0, 1); PG8_SCHED; PG8_LDA(At, 0, 0); PG8_STAGE(PG8_SA(1, 1), a1 + hstep, voffA);
            PG8_WAIT_V(8); PG8_WAIT_L(0); PG8_BAR; PG8_MMA(0, 0, At, B0); PG8_MMA(0, 1, At, B1); PG8_BAR; PG8_SCHED;
            PG8_LDA(At, 0, 1); PG8_STAGE(PG8_SB(0, 0), b2, voffB); PG8_STAGE(PG8_SB(0, 1), b2 + hstep, voffB); PG8_STAGE(PG8_SA(0, 0), a2, voffA);
            PG8_WAIT_V(8); PG8_WAIT_L(0); PG8_BAR; PG8_MMA(1, 0, At, B0); PG8_MMA(1, 1, At, B1); PG8_BAR; PG8_SCHED;
            PG8_LDB(B0, 1, 0); PG8_LDB(B1, 1, 1); PG8_SCHED; PG8_LDA(At, 1, 0); PG8_STAGE(PG8_SA(0, 1), a2 + hstep, voffA);
            PG8_WAIT_V(8); PG8_WAIT_L(0); PG8_BAR; PG8_MMA(0, 0, At, B0); PG8_MMA(0, 1, At, B1); PG8_BAR; PG8_SCHED;
            PG8_LDA(At, 1, 1); PG8_STAGE(PG8_SB(1, 0), b3, voffB); PG8_STAGE(PG8_SB(1, 1), b3 + hstep, voffB); PG8_STAGE(PG8_SA(1, 0), a3, voffA);
            PG8_WAIT_V(8); PG8_WAIT_L(0); PG8_BAR; PG8_MMA(1, 0, At, B0); PG8_MMA(1, 1, At, B1); PG8_BAR; PG8_SCHED;
            } else {
            PG8_LDB(B0, 0, 0); PG8_SCHED; PG8_LDA(At, 0, 0); PG8_STAGE(PG8_SA(1, 1), a1 + hstep, voffA);
            PG8_WAIT_L(8); PG8_BAR; PG8_WAIT_L(0); PG8_MMA(0, 0, At, B0); PG8_BAR; PG8_SCHED;
            PG8_LDB(B1, 0, 1); PG8_STAGE(PG8_SB(0, 0), b2, voffB);
            PG8_BAR; PG8_WAIT_L(0); PG8_MMA(0, 1, At, B1); PG8_BAR;
            PG8_LDA(At, 0, 1); PG8_STAGE(PG8_SA(0, 0), a2, voffA);
            PG8_BAR; PG8_WAIT_L(0); PG8_MMA(1, 0, At, B0); PG8_BAR; PG8_SCHED;
            PG8_STAGE(PG8_SB(0, 1), b2 + hstep, voffB);
            PG8_WAIT_V(6); PG8_BAR; PG8_MMA(1, 1, At, B1); PG8_BAR;
            PG8_LDB(B0, 1, 0); PG8_SCHED; PG8_LDA(At, 1, 0); PG8_STAGE(PG8_SA(0, 1), a2 + hstep, voffA);
            PG8_WAIT_L(8); PG8_BAR; PG8_WAIT_L(0); PG8_MMA(0, 0, At, B0); PG8_BAR; PG8_SCHED;
            PG8_LDB(B1, 1, 1); PG8_STAGE(PG8_SB(1, 0), b3, voffB);
            PG8_BAR; PG8_WAIT_L(0); PG8_MMA(0, 1, At, B1); PG8_BAR;
            PG8_LDA(At, 1, 1); PG8_STAGE(PG8_SA(1, 0), a3, voffA);
            PG8_BAR; PG8_WAIT_L(0); PG8_MMA(1, 0, At, B0); PG8_BAR; PG8_SCHED;
            PG8_STAGE(PG8_SB(1, 1), b3 + hstep, voffB);
            PG8_WAIT_V(6); PG8_BAR; PG8_MMA(1, 1, At, B1); PG8_BAR;
            }
        }
        if constexpr (ALIGN_EPI) { if (wr == 0) PG8_BAR; }
        E(acc, cur, wr, wc, fr, fq); S.done(cur);
        if (!has_next) break;
#pragma unroll
        for (int a = 0; a < 2; ++a)
#pragma unroll
            for (int b = 0; b < 2; ++b)
#pragma unroll
                for (int m = 0; m < 4; ++m)
#pragma unroll
                    for (int n = 0; n < 2; ++n) acc[a][b][m][n] = (f32x4){0.f, 0.f, 0.f, 0.f};
        cur = nxt; cA = nA; cB = nB; ++ui;
        if constexpr (ALIGN_EPI) { if (wr == 1) PG8_BAR; }
    }
    PG8_WAIT_V(0);
    if constexpr (!ALIGN_EPI) { if (wr == 0) PG8_BAR; }
    PG8_BAR;
#undef PG8_SA
#undef PG8_SB
#undef PG8_STAGE
#undef PG8_LDA
#undef PG8_LDB
#undef PG8_MMA
#undef PG8_WAIT_V
#undef PG8_WAIT_L
#undef PG8_BAR
#undef PG8_SCHED
}
#else
__device__ __forceinline__ unsigned cvt_pk_bf16(float lo, float hi) { return pk2(lo, hi); }
template <class Epi, class Sched, bool ALIGN_EPI = false, bool SP2 = false>
__device__ __forceinline__ void gemm_phase(unsigned char*, const Gemm g, const Sched& S, const Epi& E) {
    const int tid = threadIdx.x, wid = tid >> 6, lane = tid & 63, wr = wid >> 2, wc = wid & 3, fr = lane & 15, fq = lane >> 4;
    Unit u;
    for (int ui = 0; S.next(ui, u); ++ui) {
        f32x4 acc[2][2][4][2];
        for (int ai = 0; ai < 2; ++ai) for (int m = 0; m < 4; ++m) {
            const int r = 256 * u.pm + 128 * ai + 64 * wr + 16 * m + fr;
            const u16* ar = g.A + (size_t)r * g.K;
            for (int bj = 0; bj < 2; ++bj) for (int n = 0; n < 2; ++n) for (int i = 0; i < 4; ++i) {
                const int cc = 256 * u.pn + 128 * bj + 32 * wc + (Epi::PERM ? (8 * fq + 4 * n + i) : (16 * n + 4 * fq + i));
                const u16* br = g.Bt + (size_t)cc * g.K;
                float s0 = 0.f, s1 = 0.f, s2 = 0.f, s3 = 0.f;
                for (int k = 0; k < g.K; k += 4) { s0 += bf2f(ar[k]) * bf2f(br[k]); s1 += bf2f(ar[k + 1]) * bf2f(br[k + 1]); s2 += bf2f(ar[k + 2]) * bf2f(br[k + 2]); s3 += bf2f(ar[k + 3]) * bf2f(br[k + 3]); }
                acc[ai][bj][m][n][i] = (s0 + s1) + (s2 + s3);
            }
        }
        E(acc, u, wr, wc, fr, fq);
    }
    __syncthreads();
}
#endif

struct EpiInProj {
    static constexpr bool PERM = true;
    u16* P; float* gates; const float* b_gate;
    __device__ __forceinline__ void operator()(const f32x4 (&acc)[2][2][4][2], const Unit& u, int wr, int wc, int fr, int fq) const {
        const int row0 = u.pm * BM + wr * 64 + fr;
        if (u.pn < 16) {
            const int col0 = u.pn * BM + wc * 32 + 8 * fq;
#pragma unroll
            for (int ai = 0; ai < 2; ++ai)
#pragma unroll
                for (int m = 0; m < 4; ++m) { u16* rowp = P + (size_t)(row0 + ai * HALF + m * 16) * PLD + col0;
#pragma unroll
                    for (int bj = 0; bj < 2; ++bj) { const f32x4 v0 = acc[ai][bj][m][0], v1 = acc[ai][bj][m][1];
                        u32x4 w; w.x = cvt_pk_bf16(v0[0], v0[1]); w.y = cvt_pk_bf16(v0[2], v0[3]); w.z = cvt_pk_bf16(v1[0], v1[1]); w.w = cvt_pk_bf16(v1[2], v1[3]);
                        *(u32x4*)(rowp + bj * HALF) = w; } }
        } else if (wc == 0) {
            const int c0 = 8 * fq;
            float bg[8];
#pragma unroll
            for (int i = 0; i < 8; ++i) bg[i] = b_gate[c0 + i];
#pragma unroll
            for (int ai = 0; ai < 2; ++ai)
#pragma unroll
                for (int m = 0; m < 4; ++m) { float* rowp = gates + (size_t)(row0 + ai * HALF + m * 16) * NG + c0;
                    const f32x4 v0 = acc[ai][0][m][0], v1 = acc[ai][0][m][1];
                    *(f32x4*)(rowp) = (f32x4){v0[0] + bg[0], v0[1] + bg[1], v0[2] + bg[2], v0[3] + bg[3]};
                    *(f32x4*)(rowp + 4) = (f32x4){v1[0] + bg[4], v1[1] + bg[5], v1[2] + bg[6], v1[3] + bg[7]}; }
        }
    }
};
struct EpiBf16 {
    static constexpr bool PERM = true;
    u16* O; int ldc;
    __device__ __forceinline__ void operator()(const f32x4 (&acc)[2][2][4][2], const Unit& u, int wr, int wc, int fr, int fq) const {
        const int row0 = u.pm * BM + wr * 64 + fr, col0 = u.pn * BM + wc * 32 + 8 * fq;
#pragma unroll
        for (int ai = 0; ai < 2; ++ai)
#pragma unroll
            for (int m = 0; m < 4; ++m) { u16* rowp = O + (size_t)(row0 + ai * HALF + m * 16) * ldc + col0;
#pragma unroll
                for (int bj = 0; bj < 2; ++bj) { const f32x4 v0 = acc[ai][bj][m][0], v1 = acc[ai][bj][m][1];
                    u32x4 w; w.x = cvt_pk_bf16(v0[0], v0[1]); w.y = cvt_pk_bf16(v0[2], v0[3]); w.z = cvt_pk_bf16(v1[0], v1[1]); w.w = cvt_pk_bf16(v1[2], v1[3]);
                    *(u32x4*)(rowp + bj * HALF) = w; } }
    }
};
struct EpiResid {
    static constexpr bool PERM = false;
    const float* xl; const float* xc; float* XS; const float* ga;
    __device__ __forceinline__ void operator()(const f32x4 (&acc)[2][2][4][2], const Unit& u, int wr, int wc, int fr, int fq) const {
        const int row0 = u.pm * BM + wr * 64 + fr, col0 = u.pn * BM + wc * 32 + 4 * fq;
#pragma unroll
        for (int ai = 0; ai < 2; ++ai)
#pragma unroll
            for (int m = 0; m < 4; ++m) {
                const int row = row0 + ai * HALF + m * 16;
                const int mi = row < ML ? (row / T) : 2;
                const float* bp = row < ML ? xl + (size_t)row * D : xc + (size_t)(row - ML) * D;
                const float* gp = ga + (size_t)mi * 12288;
#pragma unroll
                for (int bj = 0; bj < 2; ++bj)
#pragma unroll
                    for (int n = 0; n < 2; ++n) { const int c = col0 + bj * HALF + n * 16;
                        const f32x4 b4 = *(const f32x4*)(bp + c), g4 = *(const f32x4*)(gp + c);
                        *(f32x4*)(XS + (size_t)row * D + c) = b4 + g4 * acc[ai][bj][m][n]; }
            }
    }
};
template <bool IN_BF16> struct EpiResidB {
    static constexpr bool PERM = true;
    const void* xl; const void* xc; u16* XS; const float* ga;
    __device__ __forceinline__ void operator()(const f32x4 (&acc)[2][2][4][2], const Unit& u, int wr, int wc, int fr, int fq) const {
        const int row0 = u.pm * BM + wr * 64 + fr, col0 = u.pn * BM + wc * 32 + 8 * fq;
#pragma unroll
        for (int ai = 0; ai < 2; ++ai)
#pragma unroll
            for (int m = 0; m < 4; ++m) {
                const int row = row0 + ai * HALF + m * 16;
                const int mi = row < ML ? (row / T) : 2;
                const float* gp = ga + (size_t)mi * 12288;
#pragma unroll
                for (int bj = 0; bj < 2; ++bj) { const int c = col0 + bj * HALF;
                    const f32x4 v0 = acc[ai][bj][m][0], v1 = acc[ai][bj][m][1];
                    const f32x4 g0 = *(const f32x4*)(gp + c), g1 = *(const f32x4*)(gp + c + 4);
                    f32x4 b0, b1;
                    if constexpr (IN_BF16) { const u16* bp = row < ML ? (const u16*)xl + (size_t)row * D : (const u16*)xc + (size_t)(row - ML) * D;
                        const u32x4 r = *(const u32x4*)(bp + c);
                        b0 = (f32x4){lo16(r.x), hi16(r.x), lo16(r.y), hi16(r.y)}; b1 = (f32x4){lo16(r.z), hi16(r.z), lo16(r.w), hi16(r.w)};
                    } else { const float* bp = row < ML ? (const float*)xl + (size_t)row * D : (const float*)xc + (size_t)(row - ML) * D;
                        b0 = *(const f32x4*)(bp + c); b1 = *(const f32x4*)(bp + c + 4); }
                    const f32x4 o0 = b0 + g0 * v0, o1 = b1 + g1 * v1;
                    u32x4 w; w.x = cvt_pk_bf16(o0[0], o0[1]); w.y = cvt_pk_bf16(o0[2], o0[3]); w.z = cvt_pk_bf16(o1[0], o1[1]); w.w = cvt_pk_bf16(o1[2], o1[3]);
                    *(u32x4*)(XS + (size_t)row * D + c) = w; }
            }
    }
};
}

#ifndef CPU_EMU
#define GAS __attribute__((address_space(1)))
#define LAS __attribute__((address_space(3)))
#define XB_TMO      128
#define XB_XCNT(j)  (256  + 64 * (j))
#define XB_XSUB(j)  (1280 + 64 * (j))
#define XB_XGEN(j)  (2304 + 64 * (j))
#define XB_TOP      3328
#define XB_TOPGEN   3392
#define XCD_BAR_WORDS 3456
#define XB_SPIN_CAP (1u << 24)
__device__ __forceinline__ unsigned xb_ld(unsigned* p)              { return __hip_atomic_load(p, __ATOMIC_RELAXED, __HIP_MEMORY_SCOPE_AGENT); }
__device__ __forceinline__ unsigned xb_add(unsigned* p, unsigned v) { return __hip_atomic_fetch_add(p, v, __ATOMIC_RELAXED, __HIP_MEMORY_SCOPE_AGENT); }
__device__ __forceinline__ unsigned xb_xcc_id() { return (unsigned)__builtin_amdgcn_s_getreg((3 << 11) | 20) & 0xFu; }
#define XB_SPIN(cond, bar) do { unsigned _sp = 0; while (cond) { __builtin_amdgcn_s_sleep(1); \
    if ((++_sp & 255u) == 0u) { if (xb_ld(&(bar)[XB_TMO])) break; if (_sp > XB_SPIN_CAP) { atomicAdd(&(bar)[XB_TMO], 1u); break; } } } } while (0)
struct XcdBarrier { unsigned* bar; unsigned x; volatile LAS unsigned* st; };
__device__ __forceinline__ XcdBarrier xcd_barrier_post(unsigned* bar, volatile LAS unsigned* st) {
    XcdBarrier b; b.bar = bar; b.x = xb_xcc_id(); b.st = st;
    if (threadIdx.x == 0) (void)xb_add(&bar[XB_XCNT(b.x)], 1u);
    return b;
}
__device__ __forceinline__ void xcd_barrier_complete(unsigned* bar, unsigned x, unsigned& nloc, unsigned& nx) {
    const unsigned G = gridDim.x * gridDim.y * gridDim.z;
    unsigned sum, cnt, mine, sp = 0u;
    for (;;) {
        sum = 0u; cnt = 0u; mine = 0u;
#pragma unroll
        for (unsigned j = 0; j < 16; ++j) { const unsigned c = xb_ld(&bar[XB_XCNT(j)]); sum += c; cnt += (c > 0u) ? 1u : 0u; mine = (j == x) ? c : mine; }
        if (sum == G) break;
        __builtin_amdgcn_s_sleep(1);
        if ((++sp & 255u) == 0u) { if (xb_ld(&bar[XB_TMO])) break; if (sp > XB_SPIN_CAP) { atomicAdd(&bar[XB_TMO], 1u); break; } }
    }
    nloc = mine > 0u ? mine : 1u; nx = cnt > 0u ? cnt : 1u;
}
__device__ __forceinline__ void xcd_barrier(const XcdBarrier& b) {
    asm volatile("s_waitcnt vmcnt(0)" ::: "memory");
    __syncthreads();
    if (threadIdx.x == 0) {
        unsigned* bar = b.bar;
        __builtin_amdgcn_s_waitcnt(0);
        unsigned nloc = b.st[0], nx = b.st[1];
        if (nloc == 0u) { xcd_barrier_complete(bar, b.x, nloc, nx); b.st[0] = nloc; b.st[1] = nx; }
        const unsigned old = xb_add(&bar[XB_XSUB(b.x)], 1u);
        const unsigned gen = old / nloc;
        if (old + 1u == (gen + 1u) * nloc) {
            __builtin_amdgcn_fence(__ATOMIC_RELEASE, "agent");
            asm volatile("s_waitcnt vmcnt(0)" ::: "memory");
            const unsigned og = xb_add(&bar[XB_TOP], 1u);
            const unsigned tg = og / nx;
            if (og + 1u == (tg + 1u) * nx) xb_add(&bar[XB_TOPGEN], 1u);
            else XB_SPIN(xb_ld(&bar[XB_TOPGEN]) == tg, bar);
            __builtin_amdgcn_fence(__ATOMIC_ACQUIRE, "agent");
            xb_add(&bar[XB_XGEN(b.x)], 1u);
            asm volatile("s_waitcnt vmcnt(0)" ::: "memory");
        } else {
            XB_SPIN(xb_ld(&bar[XB_XGEN(b.x)]) == gen, bar);
            __builtin_amdgcn_fence(__ATOMIC_ACQUIRE, "agent");
            asm volatile("s_waitcnt vmcnt(0)" ::: "memory");
        }
    }
    __syncthreads();
}
#endif

constexpr int LDS_RING = 131072, LDS_MISC = LDS_RING, LDS_BYTES = 147456;

__device__ __forceinline__ int chunk_row0(int b, int cidx) { return cidx < NCC ? ML + b * TC + 64 * cidx : b * T + 64 * (cidx - NCC); }

__device__ __forceinline__ void transpose_item(const float* W, int K, int N, u16* WT, float* scr, int kb, int nb, int lane) {
    const int k0 = 64 * kb, n0 = 32 * nb;
    f32x4 v[8];
#pragma unroll
    for (int i = 0; i < 8; ++i) v[i] = *(const f32x4*)(W + (size_t)(k0 + 8 * i + (lane >> 3)) * N + n0 + 4 * (lane & 7));
#pragma unroll
    for (int i = 0; i < 8; ++i) { float* d = scr + (8 * i + (lane >> 3)) * 33 + 4 * (lane & 7); d[0] = v[i][0]; d[1] = v[i][1]; d[2] = v[i][2]; d[3] = v[i][3]; }
    WAVE_SYNC();
    const int c = lane & 7;
#pragma unroll
    for (int j = 0; j < 4; ++j) { const int n = (lane >> 3) + 8 * j; const float* s = scr + (8 * c) * 33 + n;
        u32x4 o; o.x = pk2(s[0 * 33], s[1 * 33]); o.y = pk2(s[2 * 33], s[3 * 33]); o.z = pk2(s[4 * 33], s[5 * 33]); o.w = pk2(s[6 * 33], s[7 * 33]);
        *(u32x4*)(WT + (size_t)(n0 + n) * K + k0 + 8 * c) = o; }
    WAVE_SYNC();
}
__device__ __forceinline__ void cvt8(const float* src, u16* dst) {
    const f32x4 a = *(const f32x4*)src, b = *(const f32x4*)(src + 4);
    u32x4 o; o.x = pk2(a[0], a[1]); o.y = pk2(a[2], a[3]); o.z = pk2(b[0], b[1]); o.w = pk2(b[2], b[3]);
    *(u32x4*)dst = o;
}
constexpr int CW_PQ = 8192;
constexpr int PQ_FOLD = 2 * 4 * 128, PQ_MODP = 2 * 32 * 48, PQ_TR = (2 * (97 * 32 + 2 * 64 * 32) + 3) / 4, PQ_EX = 0, PQ_MISC = 2 * 28 + 16;
constexpr int CW_EQ = 8192 + 64, EQ_ITEMS = (2 * NK * NK) / 8;
constexpr int PQ_B1 = PQ_FOLD, PQ_B2 = PQ_B1 + PQ_MODP, PQ_B3 = PQ_B2 + PQ_TR, PQ_B4 = PQ_B3 + PQ_EX, PQ_END = PQ_B4 + PQ_MISC;
__device__ __forceinline__ void gen_fold_matrix(unsigned char* ws, int bid, int G, int tid) {
    u16* MQ = (u16*)(ws + WS_MQ);
    if (tid < 256) for (int q = bid; q < 256; q += G) {
        const int ph = q <= 128 ? (tid * q) & 255 : (tid * (q - 128) - 64) & 255;
        const float v = cos_rev((float)ph / 256.0f);
        MQ[q * 256 + tid] = (u16)f2bf(q <= 128 ? v : -v);
    }
}
__device__ __forceinline__ void pro_fold_item(const KArgs& a, const Ctx& c, float* tilef, int it) {
    unsigned char* ws = a.ws;
    const int kb = it % 128, g = (it / 128) % 4, l = it / 512;
    const float* W = a.in[8] + (size_t)l * D * 4128 + (size_t)(kb * 16) * 4128 + g * 256;
    u16* tile = (u16*)tilef;
#pragma unroll
    for (int i = 0; i < 16; ++i) { const f32x4 w = *(const f32x4*)(W + (size_t)i * 4128 + c.lane * 4);
        *(u32x2*)(tile + i * 264 + c.lane * 4) = (u32x2){pk2(w[0], w[1]), pk2(w[2], w[3])}; }
    WAVE_SYNC();
    bf16x8 wf[8];
#pragma unroll
    for (int ks = 0; ks < 8; ++ks) wf[ks] = ld_frag(tile, 0, ks * 32, 264, c.lane);
    const u16* MQ = (const u16*)(ws + WS_MQ) + (c.lane & 15) * 256 + 8 * (c.lane >> 4);
    u16* o = (u16*)(ws + WS_WIN) + ((size_t)l * PWP + g * 256 + (c.lane & 15)) * D + kb * 16 + 4 * (c.lane >> 4);
#pragma unroll 2
    for (int qt = 0; qt < 16; ++qt) {
        f32x4 acc = {0.f, 0.f, 0.f, 0.f};
#pragma unroll
        for (int ks = 0; ks < 8; ++ks) acc = MFMA_T(wf[ks], *(const bf16x8*)(MQ + qt * 16 * 256 + ks * 32), acc);
        *(u32x2*)(o + (size_t)qt * 16 * D) = (u32x2){pk2(acc[0], acc[1]), pk2(acc[2], acc[3])};
    }
    WAVE_SYNC();
}
__device__ __forceinline__ void pro_modp_item(const KArgs& a, const Ctx& c, int it) {
    const float* w_mod = a.in[4]; const float* cv = a.in[1]; const float* cc = a.in[3]; float* MODP = (float*)(a.ws + WS_MODP);
    const int strip = it % 48, ks = (it / 48) % 32, l = it / (48 * 32);
    const float* W = w_mod + ((size_t)l * D + ks * 64) * 12288 + strip * 256 + c.lane * 4;
    f32x4 a0 = {0.f, 0.f, 0.f, 0.f}, a1 = a0, a2 = a0;
    const float sv0 = siluf_(cv[ks * 64 + c.lane]), sv1 = siluf_(cv[D + ks * 64 + c.lane]), sv2 = siluf_(cc[ks * 64 + c.lane]);
#pragma unroll 16
    for (int k = 0; k < 64; ++k) { const f32x4 w = *(const f32x4*)(W + (size_t)k * 12288);
        const float s0 = bcast_lane_f(sv0, k), s1 = bcast_lane_f(sv1, k), s2 = bcast_lane_f(sv2, k);
        a0 += w * s0; a1 += w * s1; a2 += w * s2; }
    float* o = MODP + ((size_t)(ks * 2 + l) * 3) * 12288 + strip * 256 + c.lane * 4;
    *(f32x4*)o = a0; *(f32x4*)(o + 12288) = a1; *(f32x4*)(o + 2 * 12288) = a2;
}
__device__ __forceinline__ void pro_tr_item(const KArgs& a, const Ctx& c, float* scr, int it) {
    unsigned char* ws = a.ws;
    constexpr int NBI = 97 * 32, NBO = 64 * 32;
    int r = it; const int l = r / (NBI + 2 * NBO); r -= l * (NBI + 2 * NBO);
    if (l >= 2) return;
    if (r < NBI) { transpose_item(a.in[8] + (size_t)l * D * 4128, D, 4128, (u16*)(ws + WS_WIN) + (size_t)l * PWP * D, scr, r / 97, 32 + r % 97, c.lane); }
    else if (r < NBI + NBO) { r -= NBI; transpose_item(a.in[13] + (size_t)l * D * D, D, D, (u16*)(ws + WS_WOUT) + (size_t)l * D * D, scr, r / 64, r % 64, c.lane); }
    else { r -= NBI + NBO; transpose_item(a.in[14] + (size_t)l * D * D, D, D, (u16*)(ws + WS_WQ) + (size_t)l * D * D, scr, r / 64, r % 64, c.lane); }
}
__device__ __forceinline__ void pro_expert_load(const KArgs& a, const Ctx& c, int r, float (&v)[32]) {
    const int tb = r / (2 * NK * NK), row = r % (2 * NK * NK);
    const float* src = (tb ? a.in[17] : a.in[16]) + (size_t)row * D + 4 * c.lane;
#pragma unroll
    for (int q = 0; q < 8; ++q) { const f32x4 t = *(const f32x4*)(src + 256 * q);
#pragma unroll
        for (int k = 0; k < 4; ++k) v[4 * q + k] = t[k]; }
}
__device__ __forceinline__ void pro_expert_store(const KArgs& a, const Ctx& c, int r, float (&v)[32]) {
    unsigned char* ws = a.ws;
    const int tb = r / (2 * NK * NK), row = r % (2 * NK * NK);
    float mx = 0.f;
#pragma unroll
    for (int k = 0; k < 32; ++k) mx = fmaxf(mx, fabsf(v[k]));
    mx = wave_max(mx);
    const float scale = mx > 0.f ? 7.5f / mx : 1.0f, inv = mx > 0.f ? mx / 7.5f : 1.0f;
#pragma unroll
    for (int k = 0; k < 32; ++k) v[k] *= scale;
    if (!tb) {
        const u32x6 pk = fp6_enc32(v);
        u32x2* dst = (u32x2*)((unsigned char*)(ws + WS_EU) + (size_t)row * EROW + 24 * c.lane);
        dst[0] = (u32x2){pk[0], pk[1]}; dst[1] = (u32x2){pk[2], pk[3]}; dst[2] = (u32x2){pk[4], pk[5]};
    } else {
        const bool b1 = (c.lane & 16) != 0;
        float w[32];
#pragma unroll
        for (int cc = 0; cc < 4; ++cc) {
#pragma unroll
            for (int k = 0; k < 4; ++k) {
                const float send = b1 ? v[4 * cc + k] : v[16 + 4 * cc + k];
                const float recv = __shfl_xor(send, 16);
                const float own = b1 ? v[16 + 4 * cc + k] : v[4 * cc + k];
                w[8 * cc + k] = b1 ? recv : own; w[8 * cc + 4 + k] = b1 ? own : recv; } }
        const u32x6 pk = fp6_enc32(w);
        const int lp = (c.lane & 15) + 16 * (c.lane >> 5);
        unsigned char* rb = (unsigned char*)(ws + WS_EV) + (size_t)row * EROW + 16 * lp;
        if (!b1) { *(u32x4*)rb = (u32x4){pk[0], pk[1], pk[2], pk[3]}; *(u32x2*)(rb + 512) = (u32x2){pk[4], pk[5]}; }
        else { *(u32x2*)(rb + 512 + 8) = (u32x2){pk[0], pk[1]}; *(u32x4*)(rb + 1024) = (u32x4){pk[2], pk[3], pk[4], pk[5]}; }
    }
    if (c.lane == 0) ((float*)(ws + (tb ? WS_VSC : WS_USC)))[row] = inv;
}
__device__ __forceinline__ void pro_expert_row(const KArgs& a, const Ctx& c, int r) { float v[32]; pro_expert_load(a, c, r, v); pro_expert_store(a, c, r, v); }
__device__ __forceinline__ void phase_proA(const KArgs& a, const Ctx& c) {
    unsigned char* ws = a.ws;
    float* scr = (float*)(c.lds + c.wave * 16384);
    for (int t = c.gw; t < PQ_END; t += c.ngw) {
        if (t < PQ_B1) pro_fold_item(a, c, scr, t);
        else if (t < PQ_B2) pro_modp_item(a, c, t - PQ_B1);
        else if (t < PQ_B3) { for (int j = 0; j < 4; ++j) pro_tr_item(a, c, scr, (t - PQ_B2) * 4 + j); }
        else { const int m = t - PQ_B4;
            if (m < 56) {
                const int l = m / 28, r0 = (m % 28) * 8; u16* wp = (u16*)(ws + WS_WIN) + ((size_t)l * PWP + 4128 + r0) * D;
                for (int i = c.lane; i < 8 * D / 8; i += 64) *(u32x4*)(wp + (size_t)i * 8) = (u32x4){0u, 0u, 0u, 0u};
            } else {
                const int k0 = (m - 56) * 4096;
                for (int i = c.lane; i < 4096; i += 64) cvt8(a.in[15] + (size_t)(k0 + i) * 8, (u16*)(ws + WS_KEYS) + (size_t)(k0 + i) * 8); }
        }
    }
}
__device__ __forceinline__ void expert_queue(const KArgs& a, const Ctx& c, int l) {
    unsigned* qctr = (unsigned*)(a.ws + WS_CTL) + CW_EQ + 64 * l;
    volatile int* tk = (volatile int*)(c.lds);
    constexpr int NT = (2 * NK * NK) / 32;
    for (;;) {
        __syncthreads();
        if (c.tid == 0) *tk = (int)atomicAdd(qctr, 1u);
        __syncthreads();
        const int t = *tk;
        if (t >= NT) break;
        const int tb = t / (NT / 2), r0 = l * NK * NK + (t % (NT / 2)) * 32 + c.wave * 4;
        const int rb = tb * (2 * NK * NK) + r0;
        float v0[32], v1[32], v2[32], v3[32];
        pro_expert_load(a, c, rb, v0); pro_expert_load(a, c, rb + 1, v1); pro_expert_load(a, c, rb + 2, v2); pro_expert_load(a, c, rb + 3, v3);
        pro_expert_store(a, c, rb, v0); pro_expert_store(a, c, rb + 1, v1); pro_expert_store(a, c, rb + 2, v2); pro_expert_store(a, c, rb + 3, v3);
    }
}
__device__ __forceinline__ void phase_proB(const KArgs& a, const Ctx& c) {
    const float* MODP = (const float*)(a.ws + WS_MODP); float* MOD = (float*)(a.ws + WS_MOD); const float* b_mod = a.in[5];
    for (int i = c.bid * 512 + c.tid; i < 2 * 3 * 12288; i += c.G * 512) {
        const int n = i % 12288, j = (i / 12288) % 3, l = i / (3 * 12288);
        float s = b_mod[l * 12288 + n];
        for (int ks = 0; ks < 32; ++ks) s += MODP[((size_t)(ks * 2 + l) * 3 + j) * 12288 + n];
        MOD[i] = s;
    }
}
__device__ __forceinline__ void rms_mod_store(const float (&x)[32], float rstd, const float* g, const float* shift, const float* scale, u16* hrow, int lane) {
#pragma unroll
    for (int j = 0; j < 4; ++j) { const int c0 = 512 * j + 8 * lane; float y[8];
#pragma unroll
        for (int k = 0; k < 8; ++k) y[k] = x[8 * j + k] * rstd * g[c0 + k] * (1.0f + scale[c0 + k]) + shift[c0 + k];
        u32x4 o; o.x = pk2(y[0], y[1]); o.y = pk2(y[2], y[3]); o.z = pk2(y[4], y[5]); o.w = pk2(y[6], y[7]);
        *(u32x4*)(hrow + c0) = o; }
}
template <bool IN_BF16> __device__ __forceinline__ void phase_rmsmod(const KArgs& a, const Ctx& c, const void* xl_, const void* xc_, const float* g, const float* modl, int which  , int nrows) {
    u16* H = (u16*)(a.ws + WS_H);
    float gs[32], sh[32]; int cur_mi = -1;
#pragma unroll
    for (int k = 0; k < 32; ++k) { gs[k] = 0.f; sh[k] = 0.f; }
    for (int row = c.gw; row < nrows; row += 2 * c.ngw) {
        const int rowb = row + c.ngw; const bool hasb = rowb < nrows; const int rb = hasb ? rowb : row;
        float xa[32], xb[32];
        if constexpr (IN_BF16) {
            const u16* xl = (const u16*)xl_; const u16* xc = (const u16*)xc_;
            const u16* xra = row < ML ? xl + (size_t)row * D : xc + (size_t)(row - ML) * D;
            const u16* xrb = rb < ML ? xl + (size_t)rb * D : xc + (size_t)(rb - ML) * D;
            u32x4 ra[4], rbv[4];
#pragma unroll
            for (int j = 0; j < 4; ++j) ra[j] = *(const u32x4*)(xra + 512 * j + 8 * c.lane);
#pragma unroll
            for (int j = 0; j < 4; ++j) rbv[j] = *(const u32x4*)(xrb + 512 * j + 8 * c.lane);
#pragma unroll
            for (int j = 0; j < 4; ++j) {
                xa[8 * j] = lo16(ra[j].x); xa[8 * j + 1] = hi16(ra[j].x); xa[8 * j + 2] = lo16(ra[j].y); xa[8 * j + 3] = hi16(ra[j].y); xa[8 * j + 4] = lo16(ra[j].z); xa[8 * j + 5] = hi16(ra[j].z); xa[8 * j + 6] = lo16(ra[j].w); xa[8 * j + 7] = hi16(ra[j].w);
                xb[8 * j] = lo16(rbv[j].x); xb[8 * j + 1] = hi16(rbv[j].x); xb[8 * j + 2] = lo16(rbv[j].y); xb[8 * j + 3] = hi16(rbv[j].y); xb[8 * j + 4] = lo16(rbv[j].z); xb[8 * j + 5] = hi16(rbv[j].z); xb[8 * j + 6] = lo16(rbv[j].w); xb[8 * j + 7] = hi16(rbv[j].w); }
        } else {
            const float* xl = (const float*)xl_; const float* xc = (const float*)xc_;
            const float* xra = row < ML ? xl + (size_t)row * D : xc + (size_t)(row - ML) * D;
            const float* xrb = rb < ML ? xl + (size_t)rb * D : xc + (size_t)(rb - ML) * D;
#pragma unroll
            for (int j = 0; j < 4; ++j) { const f32x4 v0 = *(const f32x4*)(xra + 512 * j + 8 * c.lane), v1 = *(const f32x4*)(xra + 512 * j + 8 * c.lane + 4);
#pragma unroll
                for (int k = 0; k < 4; ++k) { xa[8 * j + k] = v0[k]; xa[8 * j + 4 + k] = v1[k]; } }
#pragma unroll
            for (int j = 0; j < 4; ++j) { const f32x4 v0 = *(const f32x4*)(xrb + 512 * j + 8 * c.lane), v1 = *(const f32x4*)(xrb + 512 * j + 8 * c.lane + 4);
#pragma unroll
                for (int k = 0; k < 4; ++k) { xb[8 * j + k] = v0[k]; xb[8 * j + 4 + k] = v1[k]; } }
        }
#pragma unroll
        for (int half = 0; half < 2; ++half) {
            if (half == 1 && !hasb) break;
            const int r = half ? rowb : row; const float (&x)[32] = half ? xb : xa;
            const int mi = r < ML ? r / T : 2;
            if (mi != cur_mi) { cur_mi = mi;
                const float* mp = modl + (size_t)mi * 12288 + which * 3 * 2048;
#pragma unroll
                for (int j = 0; j < 4; ++j) { const int c0 = 512 * j + 8 * c.lane;
#pragma unroll
                    for (int k = 0; k < 8; ++k) { gs[8 * j + k] = g[c0 + k] * (1.0f + mp[2048 + c0 + k]); sh[8 * j + k] = mp[c0 + k]; } } }
            float ss = 0.f;
#pragma unroll
            for (int k = 0; k < 32; ++k) ss += x[k] * x[k];
            ss = wave_sum(ss);
            const float rstd = 1.0f / sqrtf(ss * (1.0f / D) + EPS);
            u16* hrow = H + (size_t)r * D;
#pragma unroll
            for (int j = 0; j < 4; ++j) { float y[8];
#pragma unroll
                for (int k = 0; k < 8; ++k) y[k] = x[8 * j + k] * rstd * gs[8 * j + k] + sh[8 * j + k];
                u32x4 o; o.x = pk2(y[0], y[1]); o.y = pk2(y[2], y[3]); o.z = pk2(y[4], y[5]); o.w = pk2(y[6], y[7]);
                *(u32x4*)(hrow + 512 * j + 8 * c.lane) = o; }
        }
    }
}
__device__ __forceinline__ void conv_taps(int row, int (&trow)[9], bool (&ok)[9]) {
    if (row < ML) {
        const int b = row / T, t = row % T, r = t >> 6, w = t & 63;
#pragma unroll
        for (int i = 0; i < 3; ++i)
#pragma unroll
            for (int j = 0; j < 3; ++j) { const int rr = r + i - 1, ww = w + j - 1; const bool o = rr >= 0 && rr < T / 64 && ww >= 0 && ww < 64;
                trow[i * 3 + j] = o ? b * T + rr * 64 + ww : row; ok[i * 3 + j] = o; }
    } else {
        const int b = (row - ML) / TC, t = (row - ML) % TC;
#pragma unroll
        for (int i = 0; i < 3; ++i)
#pragma unroll
            for (int j = 0; j < 3; ++j) { const int tt = t + j - 1; const bool o = i == 1 && tt >= 0 && tt < TC;
                trow[i * 3 + j] = o ? ML + b * TC + tt : row; ok[i * 3 + j] = o; }
    }
}
__device__ __forceinline__ u32x4 conv_finish(const u32x4 (&v)[9], const bool (&ok)[9], const float (&w)[9][8], float sc) {
    float acc[8];
#pragma unroll
    for (int k = 0; k < 8; ++k) acc[k] = 0.f;
#pragma unroll
    for (int q = 0; q < 9; ++q) { const u32x4 z = ok[q] ? v[q] : (u32x4){0u, 0u, 0u, 0u};
        acc[0] += lo16(z.x) * w[q][0]; acc[1] += hi16(z.x) * w[q][1]; acc[2] += lo16(z.y) * w[q][2]; acc[3] += hi16(z.y) * w[q][3];
        acc[4] += lo16(z.z) * w[q][4]; acc[5] += hi16(z.z) * w[q][5]; acc[6] += lo16(z.w) * w[q][6]; acc[7] += hi16(z.w) * w[q][7]; }
#pragma unroll
    for (int k = 0; k < 8; ++k) acc[k] = siluf_(acc[k]) * sc;
    u32x4 o; o.x = pk2(acc[0], acc[1]); o.y = pk2(acc[2], acc[3]); o.z = pk2(acc[4], acc[5]); o.w = pk2(acc[6], acc[7]);
    return o;
}
__device__ __forceinline__ void phase_conv(const KArgs& a, const Ctx& c, int l) {
    const u16* P = (const u16*)(a.ws + WS_P); u16* QKC = (u16*)(a.ws + WS_QKC); const float* cw = a.in[10] + (size_t)l * 9 * 1024;
    const int ch0 = (c.tid & 127) * 8; const float sc = ch0 >= 512 ? 0.125f : 1.0f;
    float w[9][8];
#pragma unroll
    for (int q = 0; q < 9; ++q) { const f32x4 w0 = *(const f32x4*)(cw + q * 1024 + ch0), w1 = *(const f32x4*)(cw + q * 1024 + ch0 + 4);
        w[q][0] = w0[0]; w[q][1] = w0[1]; w[q][2] = w0[2]; w[q][3] = w0[3]; w[q][4] = w1[0]; w[q][5] = w1[1]; w[q][6] = w1[2]; w[q][7] = w1[3]; }
    const int r0 = (c.bid * 512 + c.tid) >> 7, rs = (c.G * 512) >> 7;
    for (int row = r0; row < M; row += 2 * rs) {
        const int rowb = row + rs; const bool hasb = rowb < M;
        int ta[9], tb[9]; bool oa[9], ob[9];
        conv_taps(row, ta, oa); conv_taps(hasb ? rowb : row, tb, ob);
        u32x4 va[9], vb[9];
#pragma unroll
        for (int q = 0; q < 9; ++q) va[q] = *(const u32x4*)(P + (size_t)ta[q] * PLD + 1024 + ch0);
#pragma unroll
        for (int q = 0; q < 9; ++q) vb[q] = *(const u32x4*)(P + (size_t)tb[q] * PLD + 1024 + ch0);
        *(u32x4*)(QKC + (size_t)row * 1024 + ch0) = conv_finish(va, oa, w, sc);
        if (hasb) *(u32x4*)(QKC + (size_t)rowb * 1024 + ch0) = conv_finish(vb, ob, w, sc);
    }
}
__device__ __forceinline__ void put8T(u16* tileT, int LD, int r0, int col, const u32x4& v) {
    tileT[(r0 + 0) * LD + col] = (u16)(v.x & 0xffffu); tileT[(r0 + 1) * LD + col] = (u16)(v.x >> 16);
    tileT[(r0 + 2) * LD + col] = (u16)(v.y & 0xffffu); tileT[(r0 + 3) * LD + col] = (u16)(v.y >> 16);
    tileT[(r0 + 4) * LD + col] = (u16)(v.z & 0xffffu); tileT[(r0 + 5) * LD + col] = (u16)(v.z >> 16);
    tileT[(r0 + 6) * LD + col] = (u16)(v.w & 0xffffu); tileT[(r0 + 7) * LD + col] = (u16)(v.w >> 16);
}
constexpr int S_KTF = 0, S_KTB = 9216, S_VT = 18432, S_WF = 36864, S_WB = 37120, S_END = 37376;
struct SumPre { u32x4 k, v[2]; float g0, g1, g2, g3; };
__device__ __forceinline__ void sum_prefetch(const KArgs& a, const Ctx& c, int unit, SumPre& r) {
    const int cidx = unit % NCT, bh = unit / NCT, b = bh >> 3, h = bh & 7, row0 = chunk_row0(b, cidx);
    const u16* P = (const u16*)(a.ws + WS_P); const u16* QKC = (const u16*)(a.ws + WS_QKC);
    { const int s = c.tid >> 3, g8 = c.tid & 7; r.k = *(const u32x4*)(QKC + (size_t)(row0 + s) * 1024 + 512 + h * 64 + g8 * 8); }
#pragma unroll
    for (int i = 0; i < 2; ++i) { const int it = c.tid + 512 * i, s = it >> 4, g8 = it & 15; r.v[i] = *(const u32x4*)(P + (size_t)(row0 + s) * PLD + 2048 + h * 128 + g8 * 8); }
    r.g0 = r.g1 = r.g2 = r.g3 = 0.f;
    if (c.wave == 0) { const float* gr = (const float*)(a.ws + WS_GATES) + (size_t)(row0 + c.lane) * NG; r.g0 = gr[h]; r.g1 = gr[8 + h]; r.g2 = gr[16 + h]; r.g3 = gr[24 + h]; }
}
__device__ __forceinline__ void mlstm_summary_phase(const KArgs& a, const Ctx& c) {
    unsigned char* ws = a.ws;
    u16* KTF = (u16*)(c.lds + S_KTF); u16* KTB = (u16*)(c.lds + S_KTB); u16* VT = (u16*)(c.lds + S_VT);
    float* WF = (float*)(c.lds + S_WF); float* WB = (float*)(c.lds + S_WB);
    int unit = c.bid;
    SumPre pre;
    if (unit < 16 * NCT) sum_prefetch(a, c, unit, pre);
    while (unit < 16 * NCT) {
        const int cidx = unit % NCT, bh = unit / NCT;
        const int sidx0 = (0 * 16 + bh) * NCT + cidx, sidx1 = (1 * 16 + bh) * NCT + cidx;
        if (c.wave == 0) {
            const float igf = pre.g0, lff = logsigf_(pre.g1), igb = pre.g2, lfb = logsigf_(pre.g3);
            const float bf = prefix_sum_incl(lff, c.lane), totf = __shfl(bf, 63);
            const float bb = suffix_sum_incl(lfb, c.lane), totb = __shfl(bb, 0);
            const float af = totf - bf + igf, ab = totb - bb + igb;
            const float mf = wave_max(af), mb = wave_max(ab);
            WF[c.lane] = fexp(af - mf); WB[c.lane] = fexp(ab - mb);
            if (c.lane == 0) { float* ML_ = (float*)(ws + WS_MLOC); float* BE = (float*)(ws + WS_BEND);
                ML_[sidx0] = mf; BE[sidx0] = totf; ML_[sidx1] = mb; BE[sidx1] = totb; }
        }
        const u32x4 kraw = pre.k;
#pragma unroll
        for (int i = 0; i < 2; ++i) { const int it = c.tid + 512 * i, s = it >> 4, g8 = it & 15; put8T(VT, 72, g8 * 8, s, pre.v[i]); }
        const int nxt = unit + c.G;
        if (nxt < 16 * NCT) sum_prefetch(a, c, nxt, pre);
        __syncthreads();
        { const int s = c.tid >> 3, g8 = c.tid & 7;
            const float wf = WF[s], wb = WB[s];
            const float kv[8] = {lo16(kraw.x), hi16(kraw.x), lo16(kraw.y), hi16(kraw.y), lo16(kraw.z), hi16(kraw.z), lo16(kraw.w), hi16(kraw.w)};
#pragma unroll
            for (int e = 0; e < 8; ++e) { KTF[(g8 * 8 + e) * 72 + s] = (u16)f2bf(kv[e] * wf); KTB[(g8 * 8 + e) * 72 + s] = (u16)f2bf(kv[e] * wb); } }
        __syncthreads();
        if (c.tid < 128) { const int d = c.tid >> 6, kd = c.tid & 63; const u16* KT = d ? KTB : KTF; float sum = 0.f;
#pragma unroll 4
            for (int s = 0; s < 64; ++s) sum += bf2f(KT[kd * 72 + s]);
            ((float*)(ws + WS_NCH))[(size_t)(d ? sidx1 : sidx0) * 64 + kd] = sum; }
#pragma unroll
        for (int d = 0; d < 2; ++d) { const u16* KT = d ? KTB : KTF; u16* CC = (u16*)(ws + WS_CCH) + (size_t)(d ? sidx1 : sidx0) * 8192;
#pragma unroll
            for (int kt = 0; kt < 4; ++kt) { f32x4 acc = {0.f, 0.f, 0.f, 0.f};
#pragma unroll
                for (int ks = 0; ks < 2; ++ks) acc = MFMA_T(ld_frag(KT, kt * 16, ks * 32, 72, c.lane), ld_frag(VT, c.wave * 16, ks * 32, 72, c.lane), acc);
                const int vd = c.wave * 16 + (c.lane & 15), kd = kt * 16 + 4 * (c.lane >> 4);
                u32x2 o; o.x = pk2(acc[0], acc[1]); o.y = pk2(acc[2], acc[3]);
                *(u32x2*)(CC + vd * 64 + kd) = o; } }
        __syncthreads();
        unit = nxt;
    }
}
constexpr int SCAN_U = 12;
static_assert(NCT % SCAN_U == 0 && (32 * 2064) % 64 == 0, "scan blocking");
__device__ __forceinline__ void scan_items(const KArgs& a, const Ctx& c) {
    unsigned char* ws = a.ws;
    const float* ML_ = (const float*)(ws + WS_MLOC); const float* BE = (const float*)(ws + WS_BEND); float* MP = (float*)(ws + WS_MPV);
    for (int wi = c.bid + c.G * c.wave; wi < 32 * 2064 / 64; wi += c.G * 8) {
        const int it = wi * 64 + c.lane;
        const int seq = it / 2064, grp = it % 2064, d = seq >> 4;
        float m = 0.f; float st[4] = {0.f, 0.f, 0.f, 0.f};
        for (int step0 = 0; step0 < NCT; step0 += SCAN_U) {
            int si[SCAN_U]; float be[SCAN_U], mc[SCAN_U]; u32x2 cb[SCAN_U]; f32x4 cn[SCAN_U];
#pragma unroll
            for (int u = 0; u < SCAN_U; ++u) { const int step = step0 + u;
                const int cidx = d == 0 ? step : (step < NCC ? NCC - 1 - step : NCT - 1 - (step - NCC));
                si[u] = seq * NCT + cidx; be[u] = BE[si[u]]; mc[u] = ML_[si[u]];
                if (grp < 2048) cb[u] = *(const u32x2*)((const u16*)(ws + WS_CCH) + (size_t)si[u] * 8192 + grp * 4);
                else cn[u] = *(const f32x4*)((const float*)(ws + WS_NCH) + (size_t)si[u] * 64 + (grp - 2048) * 4); }
#pragma unroll
            for (int u = 0; u < SCAN_U; ++u) {
                const float mn = fmaxf(be[u] + m, mc[u]), fo = fexp(be[u] + m - mn), fn = fexp(mc[u] - mn);
                if (grp < 2048) {
                    u32x2 o; o.x = pk2(st[0], st[1]); o.y = pk2(st[2], st[3]);
                    *(u32x2*)((u16*)(ws + WS_CPV) + (size_t)si[u] * 8192 + grp * 4) = o;
                    st[0] = fo * st[0] + fn * lo16(cb[u].x); st[1] = fo * st[1] + fn * hi16(cb[u].x); st[2] = fo * st[2] + fn * lo16(cb[u].y); st[3] = fo * st[3] + fn * hi16(cb[u].y);
                } else {
                    *(f32x4*)((float*)(ws + WS_NPV) + (size_t)si[u] * 64 + (grp - 2048) * 4) = (f32x4){st[0], st[1], st[2], st[3]};
#pragma unroll
                    for (int k = 0; k < 4; ++k) st[k] = fo * st[k] + fn * cn[u][k];
                }
                if (grp == 0) MP[si[u]] = m;
                m = mn;
            }
        }
    }
}
constexpr int O_Q = 0, O_K = 9216, O_VT = 18432, O_CPF = 36864, O_CPB = 55296, O_PF = 73728, O_PB = 82944, O_F = 92160;
struct OutPre { u32x4 q, k, v[2], cpf[2], cpb[2]; u32x2 og[4]; float np, g0, g1, g2, g3, mpf, mpb; };
__device__ __forceinline__ void out_prefetch(const KArgs& a, const Ctx& c, int unit, OutPre& r) {
    unsigned char* ws = a.ws;
    const int cidx = unit % NCT, bh = unit / NCT, b = bh >> 3, h = bh & 7, row0 = chunk_row0(b, cidx);
    const u16* P = (const u16*)(ws + WS_P); const u16* QKC = (const u16*)(ws + WS_QKC);
    const int sidx0 = (0 * 16 + bh) * NCT + cidx, sidx1 = (1 * 16 + bh) * NCT + cidx;
    { const int s = c.tid >> 3, g8 = c.tid & 7;
        r.q = *(const u32x4*)(QKC + (size_t)(row0 + s) * 1024 + h * 64 + g8 * 8);
        r.k = *(const u32x4*)(QKC + (size_t)(row0 + s) * 1024 + 512 + h * 64 + g8 * 8); }
#pragma unroll
    for (int i = 0; i < 2; ++i) { const int it = c.tid + 512 * i;
        { const int s = it >> 4, g8 = it & 15; r.v[i] = *(const u32x4*)(P + (size_t)(row0 + s) * PLD + 2048 + h * 128 + g8 * 8); }
        { const int vd = it >> 3, g8 = it & 7;
            r.cpf[i] = *(const u32x4*)((const u16*)(ws + WS_CPV) + (size_t)sidx0 * 8192 + vd * 64 + g8 * 8);
            r.cpb[i] = *(const u32x4*)((const u16*)(ws + WS_CPV) + (size_t)sidx1 * 8192 + vd * 64 + g8 * 8); } }
#pragma unroll
    for (int jt = 0; jt < 4; ++jt) { const int j = jt * 16 + (c.lane & 15), vd = c.wave * 16 + 4 * (c.lane >> 4);
        r.og[jt] = *(const u32x2*)(P + (size_t)(row0 + j) * PLD + 3072 + h * 128 + vd); }
    r.np = 0.f;
    if (c.tid < 128) { const int d = c.tid >> 6, kd = c.tid & 63; r.np = ((const float*)(ws + WS_NPV))[(size_t)(d ? sidx1 : sidx0) * 64 + kd]; }
    r.g0 = r.g1 = r.g2 = r.g3 = r.mpf = r.mpb = 0.f;
    if (c.wave == 0) { const float* gr = (const float*)(ws + WS_GATES) + (size_t)(row0 + c.lane) * NG;
        r.g0 = gr[h]; r.g1 = gr[8 + h]; r.g2 = gr[16 + h]; r.g3 = gr[24 + h];
        r.mpf = ((const float*)(ws + WS_MPV))[sidx0]; r.mpb = ((const float*)(ws + WS_MPV))[sidx1]; }
}
__device__ __forceinline__ void mlstm_output_phase(const KArgs& a, const Ctx& c, int l, bool skip_ctx) {
    unsigned char* ws = a.ws;
    u16* Q = (u16*)(c.lds + O_Q); u16* Kt = (u16*)(c.lds + O_K); u16* VT = (u16*)(c.lds + O_VT);
    u16* CPF = (u16*)(c.lds + O_CPF); u16* CPB = (u16*)(c.lds + O_CPB); u16* PF = (u16*)(c.lds + O_PF); u16* PB = (u16*)(c.lds + O_PB);
    float* F = (float*)(c.lds + O_F);
    float *EF = F, *EB = F + 64, *RTF = F + 128, *RTB = F + 192, *INF_ = F + 256, *INB = F + 320, *MJF = F + 384, *MJB = F + 448,
          *DENF = F + 512, *DENB = F + 576, *NPF = F + 640, *NPB = F + 704, *SSQ = F + 768;
    int unit = c.bid;
    while (unit < 16 * NCT && skip_ctx && (unit % NCT) < NCC) unit += c.G;
    OutPre pre;
    if (unit < 16 * NCT) out_prefetch(a, c, unit, pre);
    while (unit < 16 * NCT) {
        const int cidx = unit % NCT, bh = unit / NCT, b = bh >> 3, h = bh & 7, row0 = chunk_row0(b, cidx);
        if (c.wave == 0) {
            const float igf = pre.g0, lff = logsigf_(pre.g1), igb = pre.g2, lfb = logsigf_(pre.g3);
            const float bf = prefix_sum_incl(lff, c.lane), bb = suffix_sum_incl(lfb, c.lane);
            const float ef = igf - bf, eb = igb - bb;
            const float pmx = prefix_max_incl(ef, c.lane), smx = suffix_max_incl(eb, c.lane);
            const float mpf = pre.mpf, mpb = pre.mpb;
            const float mjf = bf + fmaxf(mpf, pmx), mjb = bb + fmaxf(mpb, smx);
            EF[c.lane] = ef; EB[c.lane] = eb; RTF[c.lane] = bf - mjf; RTB[c.lane] = bb - mjb;
            INF_[c.lane] = fexp(bf - mjf + mpf); INB[c.lane] = fexp(bb - mjb + mpb); MJF[c.lane] = mjf; MJB[c.lane] = mjb;
        }
        { const int s = c.tid >> 3, g8 = c.tid & 7; *(u32x4*)(Q + s * 72 + g8 * 8) = pre.q; *(u32x4*)(Kt + s * 72 + g8 * 8) = pre.k; }
#pragma unroll
        for (int i = 0; i < 2; ++i) { const int it = c.tid + 512 * i;
            { const int s = it >> 4, g8 = it & 15; put8T(VT, 72, g8 * 8, s, pre.v[i]); }
            { const int vd = it >> 3, g8 = it & 7; *(u32x4*)(CPF + vd * 72 + g8 * 8) = pre.cpf[i]; *(u32x4*)(CPB + vd * 72 + g8 * 8) = pre.cpb[i]; } }
        if (c.tid < 128) { const int d = c.tid >> 6, kd = c.tid & 63; (d ? NPB : NPF)[kd] = pre.np; }
        u32x2 og[4];
#pragma unroll
        for (int jt = 0; jt < 4; ++jt) og[jt] = pre.og[jt];
        int nxt = unit + c.G;
        while (nxt < 16 * NCT && skip_ctx && (nxt % NCT) < NCC) nxt += c.G;
        if (nxt < 16 * NCT) out_prefetch(a, c, nxt, pre);
        __syncthreads();
        { const int jt = c.wave >> 1;
#pragma unroll
            for (int t2 = 0; t2 < 2; ++t2) { const int st = 2 * (c.wave & 1) + t2; f32x4 acc = {0.f, 0.f, 0.f, 0.f};
#pragma unroll
                for (int ks = 0; ks < 2; ++ks) acc = MFMA_T(ld_frag(Kt, st * 16, ks * 32, 72, c.lane), ld_frag(Q, jt * 16, ks * 32, 72, c.lane), acc);
                const int j = jt * 16 + (c.lane & 15), s0 = st * 16 + 4 * (c.lane >> 4);
                const float rf = RTF[j], rb = RTB[j]; float pf[4], pb[4];
#pragma unroll
                for (int i = 0; i < 4; ++i) { const int s_ = s0 + i;
                    pf[i] = s_ <= j ? acc[i] * fexp(rf + EF[s_]) : 0.f; pb[i] = s_ >= j ? acc[i] * fexp(rb + EB[s_]) : 0.f; }
                u32x2 o; o.x = pk2(pf[0], pf[1]); o.y = pk2(pf[2], pf[3]); *(u32x2*)(PF + j * 72 + s0) = o;
                o.x = pk2(pb[0], pb[1]); o.y = pk2(pb[2], pb[3]); *(u32x2*)(PB + j * 72 + s0) = o; } }
        __syncthreads();
        {
            const int pr = c.tid >> 2, kq = c.tid & 3, d = pr >> 6, j = pr & 63; const u16* Px = d ? PB : PF; const float* NP = d ? NPB : NPF; float qn = 0.f, ps = 0.f;
            const u32x4* qp = (const u32x4*)(Q + j * 72 + 16 * kq); const u32x4* pp = (const u32x4*)(Px + j * 72 + 16 * kq); const f32x4* np4 = (const f32x4*)(NP + 16 * kq);
#pragma unroll
            for (int h8 = 0; h8 < 2; ++h8) { const u32x4 qv = qp[h8], pv = pp[h8]; const f32x4 n0 = np4[2 * h8], n1 = np4[2 * h8 + 1];
                qn += lo16(qv.x) * n0[0] + hi16(qv.x) * n0[1] + lo16(qv.y) * n0[2] + hi16(qv.y) * n0[3] + lo16(qv.z) * n1[0] + hi16(qv.z) * n1[1] + lo16(qv.w) * n1[2] + hi16(qv.w) * n1[3];
                ps += (lo16(pv.x) + hi16(pv.x)) + (lo16(pv.y) + hi16(pv.y)) + (lo16(pv.z) + hi16(pv.z)) + (lo16(pv.w) + hi16(pv.w)); }
            qn += lane_xor1(qn); qn += lane_xor2(qn); ps += lane_xor1(ps); ps += lane_xor2(ps);
            if (kq == 0) (d ? DENB : DENF)[j] = (d ? INB : INF_)[j] * qn + ps; }
        f32x4 hacc[2][4];
#pragma unroll
        for (int d = 0; d < 2; ++d) { const u16* CP = d ? CPB : CPF; const u16* Px = d ? PB : PF; const float* IN = d ? INB : INF_;
#pragma unroll
            for (int jt = 0; jt < 4; ++jt) { f32x4 acc = {0.f, 0.f, 0.f, 0.f};
#pragma unroll
                for (int ks = 0; ks < 2; ++ks) acc = MFMA_T(ld_frag(CP, c.wave * 16, ks * 32, 72, c.lane), ld_frag(Q, jt * 16, ks * 32, 72, c.lane), acc);
                acc = acc * IN[jt * 16 + (c.lane & 15)];
#pragma unroll
                for (int ks = 0; ks < 2; ++ks) acc = MFMA_T(ld_frag(VT, c.wave * 16, ks * 32, 72, c.lane), ld_frag(Px, jt * 16, ks * 32, 72, c.lane), acc);
                hacc[d][jt] = acc; } }
        __syncthreads();
        f32x4 hv[4];
#pragma unroll
        for (int jt = 0; jt < 4; ++jt) { const int j = jt * 16 + (c.lane & 15);
            const float df = fmaxf(fabsf(DENF[j]), fexp(-MJF[j])), db = fmaxf(fabsf(DENB[j]), fexp(-MJB[j]));
            hv[jt] = hacc[0][jt] * frcp(df) + hacc[1][jt] * frcp(db);
            float ss = hv[jt][0] * hv[jt][0] + hv[jt][1] * hv[jt][1] + hv[jt][2] * hv[jt][2] + hv[jt][3] * hv[jt][3];
            ss += __shfl_xor(ss, 16); ss += __shfl_xor(ss, 32);
            if ((c.lane >> 4) == 0) SSQ[c.wave * 64 + j] = ss; }
        __syncthreads();
        { const float* gm = a.in[12] + (size_t)l * 1024 + h * 128; u16* Y = (u16*)(ws + WS_Y);
#pragma unroll
            for (int jt = 0; jt < 4; ++jt) { const int j = jt * 16 + (c.lane & 15), vd = c.wave * 16 + 4 * (c.lane >> 4);
                float tot = 0.f;
#pragma unroll
                for (int w = 0; w < 8; ++w) tot += SSQ[w * 64 + j];
                const float rstd = frsq(tot * (1.0f / 128.0f) + EPS);
                const u32x2 ov = og[jt];
                const float ogv[4] = {lo16(ov.x), hi16(ov.x), lo16(ov.y), hi16(ov.y)}; float y[4];
#pragma unroll
                for (int i = 0; i < 4; ++i) y[i] = hv[jt][i] * rstd * gm[vd + i] * sigmoidf_(ogv[i]);
                u32x2 o; o.x = pk2(y[0], y[1]); o.y = pk2(y[2], y[3]);
                *(u32x2*)(Y + (size_t)(row0 + j) * D + 1024 + h * 128 + vd) = o; } }
        __syncthreads();
        unit = nxt;
    }
}
template <int N1> __device__ __forceinline__ void gen_FA(u16* FA, int tid) {
    constexpr int LDA = 2 * N1 + 8;
    for (int i = tid; i < 4 * N1 * N1; i += 512) { const int r = i / (2 * N1), cc = i % (2 * N1), p = r / N1, k1 = r % N1, pp = cc / N1, t1 = cc % N1;
        const float ang = (float)((k1 * t1) % N1) / (float)N1; const float cs = cos_rev(ang), sn = sin_rev(ang);
        const float v = p == 0 ? (pp == 0 ? cs : sn) : (pp == 0 ? -sn : cs);
        FA[r * LDA + cc] = (u16)f2bf(v); }
}
template <int N1, int N2> __device__ __forceinline__ void stageA_prefetch(const KArgs& a, const Ctx& c, int rowbase, int g, int t2, u32x4 (&r)[(N1 * 32 + 511) / 512]) {
    const u16* P = (const u16*)(a.ws + WS_P);
#pragma unroll
    for (int i = 0; i < (N1 * 32 + 511) / 512; ++i) { const int it = c.tid + 512 * i;
        if (it < N1 * 32) { const int t1 = it >> 5, g8 = it & 31; r[i] = *(const u32x4*)(P + (size_t)(rowbase + N2 * t1 + t2) * PLD + g * 256 + g8 * 8); } }
}
template <int N1, int N2> __device__ __forceinline__ void fourier_stageA_phase(const KArgs& a, const Ctx& c, const u16* FA, u16* XT, int rb0, u16* ga0) {
    constexpr int LDA = 2 * N1 + 8, TL = N1 * N2, NR = (N1 * 32 + 511) / 512, NU = NB * 4 * N2;
    u32x4 pre[NR];
    int v = c.bid;
    if (v < NU) stageA_prefetch<N1, N2>(a, c, rb0 + (v / (4 * N2)) * TL, (v / N2) & 3, v % N2, pre);
    while (v < NU) {
        const int t2 = v % N2, g = (v / N2) & 3, b = v / (4 * N2);
        u16* GA = ga0 + (size_t)b * 4 * TL * 288;
        for (int i = c.tid; i < 144 * LDA / 8; i += 512) *(u32x4*)(XT + i * 8) = (u32x4){0u, 0u, 0u, 0u};
        __syncthreads();
#pragma unroll
        for (int i = 0; i < NR; ++i) { const int it = c.tid + 512 * i;
            if (it < N1 * 32) { const int t1 = it >> 5, g8 = it & 31; const u32x4 vv = pre[i];
                const u32 e[8] = {vv.x & 0xffffu, vv.x >> 16, vv.y & 0xffffu, vv.y >> 16, vv.z & 0xffffu, vv.z >> 16, vv.w & 0xffffu, vv.w >> 16};
#pragma unroll
                for (int k = 0; k < 8; ++k) { const int q = g8 * 8 + k;
                    if (q <= 128) XT[q * LDA + t1] = (u16)e[k]; else XT[(q - 128) * LDA + N1 + t1] = (u16)e[k]; } } }
        const int nxt = v + c.G;
        if (nxt < NU) stageA_prefetch<N1, N2>(a, c, rb0 + (nxt / (4 * N2)) * TL, (nxt / N2) & 3, nxt % N2, pre);
        __syncthreads();
        for (int id = c.wave; id < (N1 / 16) * 9; id += 8) { const int kt = id / 9, nt = id % 9;
            f32x4 ar = {0.f, 0.f, 0.f, 0.f}, ai = ar;
#pragma unroll
            for (int ks = 0; ks < N1 / 16; ++ks) { const bf16x8 bfr = ld_frag(XT, nt * 16, ks * 32, LDA, c.lane);
                ar = MFMA_T(bfr, ld_frag(FA, kt * 16, ks * 32, LDA, c.lane), ar);
                ai = MFMA_T(bfr, ld_frag(FA, N1 + kt * 16, ks * 32, LDA, c.lane), ai); }
            const int k1 = kt * 16 + (c.lane & 15), c0 = nt * 16 + 4 * (c.lane >> 4);
            const float ang = (float)((t2 * k1) % TL) / (float)TL; const float cs = cos_rev(ang), sn = sin_rev(ang);
            const f32x4 gr = ar * cs + ai * sn, gi = ai * cs - ar * sn;
            u16* o = GA + ((((size_t)g * N1 + k1) * N2 + t2) * 2) * 144 + c0;
            u32x2 w; w.x = pk2(gr[0], gr[1]); w.y = pk2(gr[2], gr[3]); *(u32x2*)o = w;
            w.x = pk2(gi[0], gi[1]); w.y = pk2(gi[2], gi[3]); *(u32x2*)(o + 144) = w; }
        __syncthreads();
        v = nxt;
    }
}
template <int N2> __device__ __forceinline__ void gen_FB(u16* FB, int tid) {
    constexpr int LDB = 2 * N2 + 8;
    for (int i = tid; i < 2 * N2 * N2; i += 512) { const int k2 = i / (2 * N2), cc = i % (2 * N2), p = cc / N2, t2 = cc % N2;
        const float ang = (float)((k2 * t2) % N2) / (float)N2;
        FB[k2 * LDB + cc] = (u16)f2bf(p == 0 ? cos_rev(ang) : sin_rev(ang)); }
}
template <int N1, int N2> __device__ __forceinline__ void fourier_stageB_unit(const KArgs& a, const Ctx& c, const u16* FB, u16* XT2, int rowbase, const u16* GA, int g, int k1, int half) {
    constexpr int LDB = 2 * N2 + 8;
    const int c0 = half ? 80 : 0, ntl = half ? 4 : 5, ng8 = ntl * 2;
    const u16* src = GA + (((size_t)g * N1 + k1) * N2) * 288;
    for (int it = c.tid; it < N2 * 2 * ng8; it += 512) { const int g8 = it % ng8, pt = it / ng8, p = pt & 1, t2 = pt >> 1;
        const u32x4 v = *(const u32x4*)(src + (size_t)(t2 * 2 + p) * 144 + c0 + g8 * 8);
        put8T(XT2, LDB, g8 * 8, p * N2 + t2, v); }
    __syncthreads();
    float* WR = (float*)(a.ws + WS_WR);
    const float scale = 1.0f / sqrtf((float)(N1 * N2) * 256.0f);
    for (int mt = c.wave; mt < N2 / 16; mt += 8)
        for (int nl = 0; nl < ntl; ++nl) { f32x4 acc = {0.f, 0.f, 0.f, 0.f};
#pragma unroll
            for (int ks = 0; ks < N2 / 16; ++ks) acc = MFMA_T(ld_frag(XT2, nl * 16, ks * 32, LDB, c.lane), ld_frag(FB, mt * 16, ks * 32, LDB, c.lane), acc);
            const int k2 = mt * 16 + (c.lane & 15), cc = c0 + nl * 16 + 4 * (c.lane >> 4), tp = k1 + N1 * k2;
            *(f32x4*)(WR + (size_t)(rowbase + tp) * 576 + g * 144 + cc) = acc * scale; }
    __syncthreads();
}
__device__ __forceinline__ void fourier_final_item(const KArgs& a, const Ctx& c, int l, int row) {
    const int rowbase = row < ML ? (row / T) * T : ML + ((row - ML) / TC) * TC, TL = row < ML ? T : TC;
    const int tp = row - rowbase, mrow = rowbase + (TL - tp) % TL;
    const float* WR = (const float*)(a.ws + WS_WR);
    float v[4][4]; float ss[4];
#pragma unroll
    for (int g = 0; g < 4; ++g) { const float* w0 = WR + (size_t)row * 576 + g * 144; const float* w1 = WR + (size_t)mrow * 576 + g * 144;
#pragma unroll
        for (int i = 0; i < 4; ++i) { const int cc = 4 * c.lane + i; v[g][i] = cc <= 128 ? w0[cc] : w1[256 - cc]; } }
#pragma unroll
    for (int g = 0; g < 4; ++g) ss[g] = v[g][0] * v[g][0] + v[g][1] * v[g][1] + v[g][2] * v[g][2] + v[g][3] * v[g][3];
#pragma unroll
    for (int g = 0; g < 4; ++g) ss[g] = wave_sum(ss[g]);
#pragma unroll
    for (int g = 0; g < 4; ++g) { const float rstd = frsq(ss[g] * (1.0f / 256.0f) + EPS);
        const f32x4 gf = *(const f32x4*)(a.in[11] + (size_t)l * 1024 + g * 256 + 4 * c.lane);
        u32x2 o; o.x = pk2(v[g][0] * rstd * gf[0], v[g][1] * rstd * gf[1]); o.y = pk2(v[g][2] * rstd * gf[2], v[g][3] * rstd * gf[3]);
        *(u32x2*)((u16*)(a.ws + WS_Y) + (size_t)row * D + g * 256 + 4 * c.lane) = o; }
}
#define CE_DESC(a, b) do { const float _hi = fmaxf(a, b), _lo = fminf(a, b); a = _hi; b = _lo; } while (0)
__device__ __forceinline__ void bitonic_sort16_desc(float (&v)[16]) {
#pragma unroll
    for (int k = 2; k <= 16; k <<= 1)
#pragma unroll
        for (int j = k >> 1; j > 0; j >>= 1)
#pragma unroll
            for (int i = 0; i < 16; ++i) { const int p = i ^ j; if (p > i) { if ((i & k) == 0) CE_DESC(v[i], v[p]); else CE_DESC(v[p], v[i]); } }
}
__device__ __forceinline__ void bitonic_merge16_desc(float (&v)[16]) {
#pragma unroll
    for (int j = 8; j > 0; j >>= 1)
#pragma unroll
        for (int i = 0; i < 16; ++i) { const int p = i ^ j; if (p > i) CE_DESC(v[i], v[p]); }
}
__device__ __forceinline__ void merge_top16(float (&a)[16], const float (&b)[16]) {
#pragma unroll
    for (int i = 0; i < 16; ++i) a[i] = fmaxf(a[i], b[15 - i]);
    bitonic_merge16_desc(a);
}
constexpr int R_KEY = 0, R_QT = 34816, R_LST = 69632;
__device__ __forceinline__ void topk_prefetch(const KArgs& a, const Ctx& c, int l, int unit, int p, u32x4 (&kq)[4], u32x4 (&qq)[4]) {
    const int h = unit & 7, row0 = (unit >> 3) * 128;
    const u16* kp = (const u16*)(a.ws + WS_KEYS) + ((size_t)((l * 8 + h) * 2 + p)) * NK * 128; const u16* QP = (const u16*)(a.ws + WS_QP);
#pragma unroll
    for (int i = 0; i < 4; ++i) { const int it = c.tid + 512 * i, n = it >> 4, g8 = it & 15;
        kq[i] = *(const u32x4*)(kp + n * 128 + g8 * 8); qq[i] = *(const u32x4*)(QP + (size_t)(row0 + n) * D + h * 256 + p * 128 + g8 * 8); }
}
__device__ __forceinline__ void peer_topk_phase(const KArgs& a, const Ctx& c, int l, int nu) {
    unsigned char* ws = a.ws;
    u16* KEY = (u16*)(c.lds + R_KEY); u16* QT = (u16*)(c.lds + R_QT); float* LST = (float*)(c.lds + R_LST);
    const int tok = c.wave * 16 + (c.lane & 15), fq = c.lane >> 4;
    u32x4 kq[4], qq[4];
    if (c.bid < nu) topk_prefetch(a, c, l, c.bid, 0, kq, qq);
    for (int unit = c.bid; unit < nu; unit += c.G) {
    const int h = unit & 7, tb = unit >> 3, row0 = tb * 128;
    float L0[16], L1[16];
#pragma unroll
    for (int p = 0; p < 2; ++p) {
#pragma unroll
        for (int i = 0; i < 4; ++i) { const int it = c.tid + 512 * i, n = it >> 4, g8 = it & 15;
            *(u32x4*)(KEY + n * 136 + g8 * 8) = kq[i]; *(u32x4*)(QT + n * 136 + g8 * 8) = qq[i]; }
        if (p == 0) topk_prefetch(a, c, l, unit, 1, kq, qq);
        else if (unit + c.G < nu) topk_prefetch(a, c, l, unit + c.G, 0, kq, qq);
        __syncthreads();
        float va[16], vb[16];
#pragma unroll
        for (int nt = 0; nt < 8; ++nt) { f32x4 acc = {0.f, 0.f, 0.f, 0.f};
#pragma unroll
            for (int ks = 0; ks < 4; ++ks) acc = MFMA_T(ld_frag(KEY, nt * 16, ks * 32, 136, c.lane), ld_frag(QT, c.wave * 16, ks * 32, 136, c.lane), acc);
#pragma unroll
            for (int i = 0; i < 4; ++i) { const float x = bitsf((fbits(acc[i]) & ~0x7fu) | (u32)(nt * 16 + 4 * fq + i));
                if (nt < 4) va[nt * 4 + i] = x; else vb[(nt - 4) * 4 + i] = x; } }
        bitonic_sort16_desc(va); bitonic_sort16_desc(vb);
        merge_top16(va, vb);
#pragma unroll
        for (int r = 0; r < 2; ++r) {
            float ob[16];
#pragma unroll
            for (int i = 0; i < 16; ++i) ob[i] = __shfl_xor(va[i], 16 << r);
            merge_top16(va, ob); }
        if (fq == 0) {
#pragma unroll
            for (int j = 0; j < 16; j += 4) *(f32x4*)(LST + (size_t)(tok * 2 + p) * 16 + j) = (f32x4){va[j], va[j + 1], va[j + 2], va[j + 3]}; }
#pragma unroll
        for (int i = 0; i < 16; ++i) { if (p == 0) L0[i] = va[i]; else L1[i] = va[i]; }
        __syncthreads();
    }
    float Tt[16];
#pragma unroll
    for (int i = 0; i < 16; ++i) Tt[i] = -INFINITY;
#pragma unroll
    for (int rr = 0; rr < 4; ++rr) {
        float R[16];
#pragma unroll
        for (int bi = 0; bi < 16; ++bi) R[bi] = -INFINITY;
#pragma unroll
        for (int q = 0; q < 4; ++q) { if (q == fq) { const int ai = 4 * rr + q;
#pragma unroll
                for (int bi = 0; bi < 16; ++bi) if ((4 * rr + q + 1) * (bi + 1) <= 16) R[bi] = bitsf((fbits(L0[ai] + L1[bi]) & ~0xffu) | (u32)(ai * 16 + bi)); } }
        merge_top16(Tt, R);
    }
#pragma unroll
    for (int r = 0; r < 2; ++r) { float ob[16];
#pragma unroll
        for (int i = 0; i < 16; ++i) ob[i] = __shfl_xor(Tt[i], 16 << r);
        merge_top16(Tt, ob); }
    {
        float sum = 0.f; float e[16];
#pragma unroll
        for (int j = 0; j < 16; ++j) { e[j] = fexp(Tt[j] - Tt[0]); sum += e[j]; }
        const float inv = frcp(sum);
        const float* A = LST + (size_t)(tok * 2) * 16; const float* B = A + 16;
        int io[4]; float go[4];
#pragma unroll
        for (int q = 0; q < 4; ++q) if (q == fq) {
#pragma unroll
            for (int j = 0; j < 4; ++j) { const u32 pos = fbits(Tt[4 * q + j]) & 0xffu; const u32 ia = fbits(A[pos >> 4]) & 0x7fu, ib = fbits(B[pos & 15]) & 0x7fu;
                io[j] = (int)(ia * NK + ib); go[j] = e[4 * q + j] * inv; } }
        int* IDX = (int*)(ws + WS_IDX) + (size_t)(row0 + tok) * 128 + h * 16 + 4 * fq; float* GW = (float*)(ws + WS_GW) + (size_t)(row0 + tok) * 128 + h * 16 + 4 * fq;
        *(u32x4*)IDX = (u32x4){(u32)io[0], (u32)io[1], (u32)io[2], (u32)io[3]}; *(f32x4*)GW = (f32x4){go[0], go[1], go[2], go[3]};
    }
    __syncthreads();
    }
}
__device__ __forceinline__ u32x6 ld_fp6row(const unsigned char* base, int lane) {
    const u32x2* p = (const u32x2*)(base + 24 * lane); const u32x2 a = p[0], b = p[1], d = p[2];
    return (u32x6){a.x, a.y, b.x, b.y, d.x, d.y};
}
__device__ __forceinline__ u32x6 ld_fp6row_off(const unsigned char* tab, int ei, int lane) {
    const u32 off = (u32)ei * (u32)EROW + 24u * (u32)lane;
    const u32x2 a = *(const u32x2*)(tab + off), b = *(const u32x2*)(tab + off + 8u), d = *(const u32x2*)(tab + off + 16u);
    return (u32x6){a.x, a.y, b.x, b.y, d.x, d.y};
}
template <int DRY> __device__ __forceinline__ void phase_peer_gather(const KArgs& a, const Ctx& c, int l, int nrows) {
    unsigned char* ws = a.ws;
    const u16* H = (const u16*)(ws + WS_H);
    const unsigned char* EU = (const unsigned char*)(ws + WS_EU) + (size_t)l * NK * NK * EROW; const unsigned char* EV = (const unsigned char*)(ws + WS_EV) + (size_t)l * NK * NK * EROW;
    const float* USC = (const float*)(ws + WS_USC) + (size_t)l * NK * NK; const float* VSC = (const float*)(ws + WS_VSC) + (size_t)l * NK * NK;
    const int* IDX = (const int*)(ws + WS_IDX); const float* GW = (const float*)(ws + WS_GW);
    u16* XS = (u16*)(ws + WS_XS); const float* MOD = (const float*)(ws + WS_MOD);
    const bool last = l == NLAYER - 1;
    const bool hi32 = c.lane >= 32;
    const int m16 = c.lane & 15, g4 = c.lane >> 4;
    const u32 amask = ((g4 & 1) == (m16 >> 3)) ? ((m16 & 1) ? 0xffff0000u : 0x0000ffffu) : 0u;
    const int ar = (m16 & 7) >> 1;
    const u32 am0 = ar == 0 ? amask : 0u, am1 = ar == 1 ? amask : 0u, am2 = ar == 2 ? amask : 0u, am3 = ar == 3 ? amask : 0u;
    const bool dg = (m16 >> 2) == g4;
    const float dm0 = dg && (c.lane & 3) == 0 ? 1.f : 0.f, dm1 = dg && (c.lane & 3) == 1 ? 1.f : 0.f, dm2 = dg && (c.lane & 3) == 2 ? 1.f : 0.f, dm3 = dg && (c.lane & 3) == 3 ? 1.f : 0.f;
    for (int row = c.gw; row - c.wave < nrows; row += c.ngw) {
        const bool sync_ok = row - c.wave + 7 < nrows;
        if (row < nrows) {
        const int mi = row < ML ? row / T : 2;
        u32 hq[16]; f32x4 od[8];
        { const u16* hp = H + (size_t)row * D + 4 * c.lane;
#pragma unroll
            for (int q = 0; q < 8; ++q) { const u32x2 r = *(const u32x2*)(hp + 256 * q); hq[2 * q] = r.x; hq[2 * q + 1] = r.y; } }
#pragma unroll
        for (int q = 0; q < 8; ++q) od[q] = (f32x4){0.f, 0.f, 0.f, 0.f};
        int* off = (int*)(c.lds + 65536) + c.wave * 40; int* irow = (int*)(c.lds) + c.wave * 128; float* grow = (float*)(c.lds + 32768) + c.wave * 128;
        {   if (c.lane < 33) off[c.lane] = 0;
            WAVE_SYNC();
            int i0 = IDX[(size_t)row * 128 + c.lane], i1 = IDX[(size_t)row * 128 + 64 + c.lane];
            if (DRY == 1) { i0 &= 3; i1 &= 3; } else if (DRY == 2) { i0 &= 511; i1 &= 511; }
            const float g0 = GW[(size_t)row * 128 + c.lane], g1 = GW[(size_t)row * 128 + 64 + c.lane];
            const int r0 = i0 >> 9, r1 = i1 >> 9;
            const int q0 = atomicAdd(&off[r0 + 1], 1), q1 = atomicAdd(&off[r1 + 1], 1);
            WAVE_SYNC();
            int inc = c.lane < 32 ? off[c.lane + 1] : 0;
#pragma unroll
            for (int o = 1; o < 32; o <<= 1) { const int t = __shfl_up(inc, o); if (c.lane >= o) inc += t; }
            WAVE_SYNC();
            if (c.lane < 32) off[c.lane + 1] = inc;
            WAVE_SYNC();
            const int d0 = off[r0] + q0, d1 = off[r1] + q1;
            irow[d0] = i0; irow[d1] = i1; grow[d0] = g0; grow[d1] = g1;
            WAVE_SYNC(); }
        float* drow = (float*)(c.lds + 49152) + c.wave * 128; float* wrow = (float*)(c.lds + 57344) + c.wave * 128;
        const int si0 = irow[c.lane], si1 = irow[64 + c.lane];
        const float us0 = USC[si0], us1 = USC[si1], vs0 = VSC[si0], vs1 = VSC[si1];
#ifdef CPU_EMU
#define G_BAR() __syncthreads()
#else
#define G_BAR() __builtin_amdgcn_s_barrier()
#endif
#define GA_LOAD(UR, IT) do { if ((IT) < 32) { const u32x4 ix_ = *(const u32x4*)(irow + (IT) * 4); \
            UR[0] = ld_fp6row_off(EU, (int)ix_.x, c.lane); UR[1] = ld_fp6row_off(EU, (int)ix_.y, c.lane); UR[2] = ld_fp6row_off(EU, (int)ix_.z, c.lane); UR[3] = ld_fp6row_off(EU, (int)ix_.w, c.lane); } } while (0)
#define GA_BODY(UR, IT) do { float part[4]; \
            _Pragma("unroll") for (int e = 0; e < 4; ++e) { u32 f[16]; fp6_dec32_bf16(UR[e], f); f32x4 dd = {0.f, 0.f, 0.f, 0.f}; \
                _Pragma("unroll") for (int k = 0; k < 4; ++k) dd = MFMA_T(mk8(f[4 * k], f[4 * k + 1], f[4 * k + 2], f[4 * k + 3]), mk8(hq[4 * k], hq[4 * k + 1], hq[4 * k + 2], hq[4 * k + 3]), dd); \
                part[e] = fmaf(dd[3], dm3, fmaf(dd[2], dm2, fmaf(dd[1], dm1, dd[0] * dm0))); } \
            float p2[2], p1; \
            { const bool hi = (c.lane & 2) != 0; _Pragma("unroll") for (int k = 0; k < 2; ++k) { const float send = hi ? part[k] : part[k + 2], keep = hi ? part[k + 2] : part[k]; p2[k] = keep + lane_xor2(send); } } \
            { const bool hi = (c.lane & 1) != 0; const float send = hi ? p2[0] : p2[1], keep = hi ? p2[1] : p2[0]; p1 = keep + lane_xor1(send); } \
            p1 = sum_lanebits_2_5(p1); \
            if (c.lane < 4) drow[(IT) * 4 + c.lane] = p1; } while (0)
        {   u32x6 ua[4], ub[4];
            GA_LOAD(ua, 0);
#pragma unroll 1
            for (int it = 0; it < 32; it += 2) {
                GA_LOAD(ub, it + 1); GA_BODY(ua, it);
                GA_LOAD(ua, it + 2); GA_BODY(ub, it + 1);
                if (sync_ok && (it & 15) == 14) G_BAR();
            } }
#undef GA_LOAD
#undef GA_BODY
        WAVE_SYNC();
        {   const float d0 = drow[c.lane], d1 = drow[64 + c.lane];
            wrow[c.lane] = grow[c.lane] * gelu_fast(d0 * us0) * vs0; wrow[64 + c.lane] = grow[64 + c.lane] * gelu_fast(d1 * us1) * vs1; }
        WAVE_SYNC();
#define GB_LOAD(VQ, IT) do { if ((IT) < 32) { _Pragma("unroll") for (int p = 0; p < 2; ++p) { const int ei = irow[(IT) * 4 + 2 * p + (hi32 ? 1 : 0)]; \
                const u32 vo = (u32)ei * (u32)EROW + 16u * (u32)(c.lane & 31); \
                _Pragma("unroll") for (int r = 0; r < 3; ++r) VQ[p][r] = *(const u32x4*)(EV + vo + 512u * r); } } } while (0)
#define GB_BODY(VQ, IT) do { _Pragma("unroll") for (int p = 0; p < 2; ++p) { const float wsel = wrow[(IT) * 4 + 2 * p + (hi32 ? 1 : 0)]; \
                const u32 wpk = pk2(wsel, wsel); \
                const bf16x8 aw = mk8(wpk & am0, wpk & am1, wpk & am2, wpk & am3); \
                u32 f0[16], f1[16]; \
                fp6_dec32_bf16((u32x6){VQ[p][0].x, VQ[p][0].y, VQ[p][0].z, VQ[p][0].w, VQ[p][1].x, VQ[p][1].y}, f0); \
                fp6_dec32_bf16((u32x6){VQ[p][1].z, VQ[p][1].w, VQ[p][2].x, VQ[p][2].y, VQ[p][2].z, VQ[p][2].w}, f1); \
                _Pragma("unroll") for (int k = 0; k < 4; ++k) od[k] = MFMA_T(aw, mk8(f0[4 * k], f0[4 * k + 1], f0[4 * k + 2], f0[4 * k + 3]), od[k]); \
                _Pragma("unroll") for (int k = 0; k < 4; ++k) od[4 + k] = MFMA_T(aw, mk8(f1[4 * k], f1[4 * k + 1], f1[4 * k + 2], f1[4 * k + 3]), od[4 + k]); } } while (0)
        {   u32x4 va[2][3], vb[2][3];
            GB_LOAD(va, 0);
#pragma unroll 1
            for (int it = 0; it < 32; it += 2) {
                GB_LOAD(vb, it + 1); GB_BODY(va, it);
                GB_LOAD(va, it + 2); GB_BODY(vb, it + 1);
                if (sync_ok && (it & 15) == 14) G_BAR();
            } }
#undef GB_LOAD
#undef GB_BODY
#undef G_BAR
        float outv[32];
#pragma unroll
        for (int q = 0; q < 8; ++q) { outv[4 * q] = od[q][0]; outv[4 * q + 1] = od[q][1]; outv[4 * q + 2] = od[q][2]; outv[4 * q + 3] = od[q][3]; }
        int row2 = row;
#ifndef CPU_EMU
        asm volatile("" : "+s"(row2));
#endif
        u16* xr = XS + (size_t)row2 * D + 4 * c.lane; const float* ga2 = MOD + ((size_t)l * 3 + mi) * 12288 + 5 * 2048 + 4 * c.lane;
        float ss = 0.f;
#pragma unroll
        for (int q = 0; q < 8; ++q) { const u32x2 xv = *(const u32x2*)(xr + 256 * q); const f32x4 v0 = {lo16(xv.x), hi16(xv.x), lo16(xv.y), hi16(xv.y)}, g0 = *(const f32x4*)(ga2 + 256 * q);
#pragma unroll
            for (int k = 0; k < 4; ++k) { const float x2 = v0[k] + g0[k] * outv[4 * q + k]; outv[4 * q + k] = x2; ss += x2 * x2; } }
        ss = wave_sum(ss);
        const float rstd = 1.0f / sqrtf(ss * (1.0f / D) + EPS);
        if (DRY != 0 && ss != 12345.678f) {   } else
        if (!last) {
            const float* mp = MOD + ((size_t)(l + 1) * 3 + mi) * 12288 + 4 * c.lane; const float* gn = a.in[6] + (size_t)(l + 1) * D + 4 * c.lane; u16* hrow = (u16*)(ws + WS_H) + (size_t)row2 * D + 4 * c.lane;
#pragma unroll
            for (int q = 0; q < 8; ++q) { float y[4];
                { u32x2 xo; xo.x = pk2(outv[4 * q], outv[4 * q + 1]); xo.y = pk2(outv[4 * q + 2], outv[4 * q + 3]); *(u32x2*)(xr + 256 * q) = xo; }
                const f32x4 g4 = *(const f32x4*)(gn + 256 * q), sh = *(const f32x4*)(mp + 256 * q), sc = *(const f32x4*)(mp + 2048 + 256 * q);
#pragma unroll
                for (int k = 0; k < 4; ++k) y[k] = outv[4 * q + k] * rstd * g4[k] * (1.0f + sc[k]) + sh[k];
                u32x2 o; o.x = pk2(y[0], y[1]); o.y = pk2(y[2], y[3]);
                *(u32x2*)(hrow + 256 * q) = o; }
        } else {
            const float* gfin = a.in[18] + 4 * c.lane; float* orow = a.out + (size_t)row2 * D + 4 * c.lane;
#pragma unroll
            for (int q = 0; q < 8; ++q) { const f32x4 g4 = *(const f32x4*)(gfin + 256 * q);
                *(f32x4*)(orow + 256 * q) = (f32x4){outv[4 * q] * rstd * g4[0], outv[4 * q + 1] * rstd * g4[1], outv[4 * q + 2] * rstd * g4[2], outv[4 * q + 3] * rstd * g4[3]}; }
        }
        }
        __syncthreads();
    }
}

constexpr int NPHASE = 3 + 10 * NLAYER;
constexpr int A_FAL = 40960, A_XT = 75776, A_FAC = 114944;
constexpr int B_FBL = 0, B_FBC = 67584, B_XT2 = 69632;
static_assert(A_FAL >= S_END && A_FAL + 2 * N1L * (2 * N1L + 8) * 2 <= A_XT && A_XT + 144 * (2 * N1L + 8) * 2 <= A_FAC && A_FAC + 2 * N1C * (2 * N1C + 8) * 2 <= LDS_RING, "phase-3 LDS map");
static_assert(B_FBL + N2L * (2 * N2L + 8) * 2 <= B_FBC && B_FBC + N2C * (2 * N2C + 8) * 2 <= B_XT2 && B_XT2 + 80 * (2 * N2L + 8) * 2 <= LDS_RING && 80 * (2 * N2C + 8) * 2 <= 80 * (2 * N2L + 8) * 2, "phase-4 LDS map");

constexpr int MG_AS = 0, MG_BS = 4608;
static_assert(MC % 32 == 0, "ctx mini-GEMM tiling");
template <int MODE> __device__ __forceinline__ void mini_gemm_ctx(const KArgs& a, const Ctx& c, const u16* A  , const u16* Bt, const void* ctx_in_, const float* ga, u16* XSc  , u16* QPc) {
    const int ntiles = (MC / 32) * 16;
    for (int tile = c.bid; tile < ntiles; tile += c.G) {
        const int mt0 = tile >> 4, nt0 = tile & 15;
        u16* As = (u16*)(c.lds + MG_AS); u16* Bs = (u16*)(c.lds + MG_BS);
        const u16* Ab = A + (size_t)(mt0 * 32) * D; const u16* Bb = Bt + (size_t)(nt0 * 128) * D;
        u32x4 ra = {0u, 0u, 0u, 0u}, rb[2];
        const int ar = c.tid >> 3, ag = c.tid & 7;
        if (c.tid < 256) ra = *(const u32x4*)(Ab + (size_t)ar * D + ag * 8);
#pragma unroll
        for (int i = 0; i < 2; ++i) { const int it = c.tid + 512 * i, br = it >> 3, bg = it & 7; rb[i] = *(const u32x4*)(Bb + (size_t)br * D + bg * 8); }
        f32x4 acc[2] = {{0.f, 0.f, 0.f, 0.f}, {0.f, 0.f, 0.f, 0.f}};
        for (int kc = 0; kc < D / 64; ++kc) {
            if (c.tid < 256) *(u32x4*)(As + ar * 72 + ag * 8) = ra;
#pragma unroll
            for (int i = 0; i < 2; ++i) { const int it = c.tid + 512 * i, br = it >> 3, bg = it & 7; *(u32x4*)(Bs + br * 72 + bg * 8) = rb[i]; }
            if (kc + 1 < D / 64) { const int k0 = (kc + 1) * 64;
                if (c.tid < 256) ra = *(const u32x4*)(Ab + (size_t)ar * D + k0 + ag * 8);
#pragma unroll
                for (int i = 0; i < 2; ++i) { const int it = c.tid + 512 * i, br = it >> 3, bg = it & 7; rb[i] = *(const u32x4*)(Bb + (size_t)br * D + k0 + bg * 8); } }
            __syncthreads();
#pragma unroll
            for (int ks = 0; ks < 2; ++ks) { const bf16x8 bf = ld_frag(Bs, c.wave * 16, ks * 32, 72, c.lane);
#pragma unroll
                for (int m = 0; m < 2; ++m) acc[m] = MFMA_T(bf, ld_frag(As, m * 16, ks * 32, 72, c.lane), acc[m]); }
            __syncthreads();
        }
#pragma unroll
        for (int m = 0; m < 2; ++m) { const int r = mt0 * 32 + m * 16 + (c.lane & 15), col = nt0 * 128 + c.wave * 16 + 4 * (c.lane >> 4);
            if (MODE == 0) { const f32x4 b4 = *(const f32x4*)((const float*)ctx_in_ + (size_t)r * D + col), g4 = *(const f32x4*)(ga + col);
                const f32x4 o4 = b4 + g4 * acc[m]; u32x2 o; o.x = pk2(o4[0], o4[1]); o.y = pk2(o4[2], o4[3]); *(u32x2*)(XSc + (size_t)r * D + col) = o; }
            else { u32x2 o; o.x = pk2(acc[m][0], acc[m][1]); o.y = pk2(acc[m][2], acc[m][3]); *(u32x2*)(QPc + (size_t)r * D + col) = o; } }
    }
}
template <class E> __device__ __forceinline__ void run_gemm(unsigned char* lds, const pg8::Gemm& g, const pg8::StaticOrder& S, const E& e) {
#ifdef CPU_EMU
    pg8::gemm_phase<E, pg8::StaticOrder, true, true>(lds, g, S, e);
#else
    pg8::gemm_phase<E, pg8::StaticOrder, true, true>((PG8_LAS unsigned char*)lds, g, S, e);
#endif
}
__device__ __forceinline__ Ctx make_ctx(unsigned char* lds, int wave0) {
#ifndef CPU_EMU
    int lane = (int)__builtin_amdgcn_mbcnt_hi(~0u, __builtin_amdgcn_mbcnt_lo(~0u, 0u));
    asm volatile("" : "+v"(lane));
    const int tid = wave0 * 64 + lane;
#else
    const int tid = threadIdx.x; (void)wave0;
#endif
    Ctx c; c.lds = lds; c.tid = tid; c.lane = tid & 63; c.wave = __builtin_amdgcn_readfirstlane(tid >> 6);
    c.bid = blockIdx.x; c.G = gridDim.x; c.gw = c.bid * 8 + c.wave; c.ngw = c.G * 8;
    return c;
}
template <int PH, int DRY = 0> __device__ __forceinline__ void run_phase(const KArgs& args, unsigned char* lds, int wave0) {
    const Ctx c = make_ctx(lds, wave0);
    unsigned char* ws = args.ws;
    const float* MOD = (const float*)(ws + WS_MOD);
    if constexpr (PH == 0) phase_proA(args, c);
    else if constexpr (PH == 1) phase_proB(args, c);
    else if constexpr (PH == 2) phase_rmsmod<false>(args, c, args.in[0], args.in[2], args.in[6], MOD, 0, M);
    else {
        constexpr int l = (PH - 3) / 10, sp = (PH - 3) % 10; constexpr bool last = l == NLAYER - 1;
        const void* xl = l == 0 ? (const void*)args.in[0] : (const void*)(ws + WS_XS);
        const void* xc = l == 0 ? (const void*)args.in[2] : (const void*)((const u16*)(ws + WS_XS) + (size_t)ML * D);
        if constexpr (sp == 0) {
            pg8::Gemm g{(const u16*)(ws + WS_H), (const u16*)(ws + WS_WIN) + (size_t)l * PWP * D, M, PWP, D};
            pg8::StaticOrder S; S.init(M, PWP, c.G, c.bid);
            pg8::EpiInProj E{(u16*)(ws + WS_P), (float*)(ws + WS_GATES), args.in[9] + l * NG};
            run_gemm(lds, g, S, E);
            expert_queue(args, c, l);
        } else if constexpr (sp == 1) phase_conv(args, c, l);
        else if constexpr (sp == 2) {
            u16* FAL = (u16*)(lds + A_FAL); u16* XT = (u16*)(lds + A_XT); u16* FAC = (u16*)(lds + A_FAC);
            gen_FA<N1L>(FAL, c.tid); gen_FA<N1C>(FAC, c.tid);
            __syncthreads();
            mlstm_summary_phase(args, c);
            fourier_stageA_phase<N1L, N2L>(args, c, FAL, XT, 0, (u16*)(ws + WS_GAL));
            if (!last) fourier_stageA_phase<N1C, N2C>(args, c, FAC, XT, ML, (u16*)(ws + WS_GAC));
        } else if constexpr (sp == 3) {
            u16* FBL = (u16*)(lds + B_FBL); u16* FBC = (u16*)(lds + B_FBC); u16* XT2 = (u16*)(lds + B_XT2);
            gen_FB<N2L>(FBL, c.tid); gen_FB<N2C>(FBC, c.tid);
            __syncthreads();
            scan_items(args, c);
            constexpr int NBL = NB * 4 * N1L * 2, NBC = NB * 4 * N1C * 2;
            constexpr int ntot = NBL + (last ? 0 : NBC);
            for (int u = c.bid; u < ntot; u += c.G) {
                if (u < NBL) { const int half = u & 1, k1 = (u >> 1) % N1L, g = ((u >> 1) / N1L) & 3, b = (u >> 1) / (4 * N1L);
                    fourier_stageB_unit<N1L, N2L>(args, c, FBL, XT2, b * T, (const u16*)(ws + WS_GAL) + (size_t)b * 4 * T * 288, g, k1, half); }
                else { const int v = u - NBL, half = v & 1, k1 = (v >> 1) % N1C, g = ((v >> 1) / N1C) & 3, b = (v >> 1) / (4 * N1C);
                    fourier_stageB_unit<N1C, N2C>(args, c, FBC, XT2, ML + b * TC, (const u16*)(ws + WS_GAC) + (size_t)b * 4 * TC * 288, g, k1, half); }
            }
        } else if constexpr (sp == 4) {
            constexpr int nrows = last ? ML : M;
            mlstm_output_phase(args, c, l, last);
            for (int it = c.gw; it < nrows; it += c.ngw) fourier_final_item(args, c, l, it);
        } else if constexpr (sp == 5) {
            pg8::Gemm g{(const u16*)(ws + WS_Y), (const u16*)(ws + WS_WOUT) + (size_t)l * D * D, ML, D, D};
            pg8::StaticOrder S; S.init(ML, D, c.G, c.bid);
            pg8::EpiResidB<(l > 0)> E{xl, xc, (u16*)(ws + WS_XS), MOD + (size_t)l * 3 * 12288 + 2 * 2048};
            run_gemm(lds, g, S, E);
            if constexpr (!last) mini_gemm_ctx<0>(args, c, (const u16*)(ws + WS_Y) + (size_t)ML * D, (const u16*)(ws + WS_WOUT) + (size_t)l * D * D, xc,
                                                  MOD + ((size_t)l * 3 + 2) * 12288 + 2 * 2048, (u16*)(ws + WS_XS) + (size_t)ML * D, nullptr);
        } else if constexpr (sp == 6) phase_rmsmod<true>(args, c, (const u16*)(ws + WS_XS), (const u16*)(ws + WS_XS) + (size_t)ML * D, args.in[7] + (size_t)l * D, MOD + (size_t)l * 3 * 12288, 1, last ? ML : M);
        else if constexpr (sp == 7) {
            pg8::Gemm g{(const u16*)(ws + WS_H), (const u16*)(ws + WS_WQ) + (size_t)l * D * D, ML, D, D};
            pg8::StaticOrder S; S.init(ML, D, c.G, c.bid);
            pg8::EpiBf16 E{(u16*)(ws + WS_QP), D};
            run_gemm(lds, g, S, E);
            if constexpr (!last) mini_gemm_ctx<1>(args, c, (const u16*)(ws + WS_H) + (size_t)ML * D, (const u16*)(ws + WS_WQ) + (size_t)l * D * D, nullptr, nullptr, nullptr,
                                                  (u16*)(ws + WS_QP) + (size_t)ML * D);
        } else if constexpr (sp == 8) { constexpr int nu = ((last ? ML : M) / 128) * 8; peer_topk_phase(args, c, l, nu); }
        else phase_peer_gather<DRY>(args, c, l, last ? ML : M);
    }
}

#ifdef CPU_EMU
#define GRID_BAR() emu_grid_sync()
static void mk_fwd(KArgs args)
#else
#define GRID_BAR() xcd_barrier(bar)
__global__ void __launch_bounds__(512, 2) mk_fwd(KArgs args)
#endif
{
#ifdef CPU_EMU
    unsigned char* lds = emu_lds();
#else
    extern __shared__ __attribute__((aligned(16))) unsigned char lds[];
#endif
    const int wave0 = __builtin_amdgcn_readfirstlane((int)threadIdx.x >> 6);
    if (args.ph_lo == 0) gen_fold_matrix(args.ws, (int)blockIdx.x, (int)gridDim.x, (int)threadIdx.x);
#ifdef CPU_EMU
    if (args.ph_lo == 0) emu_grid_sync();
#else
    if (args.ph_hi - args.ph_lo > 1) { cooperative_groups::this_grid().sync(); }
    for (int u = threadIdx.x; u < (LDS_BYTES - LDS_MISC) / 4; u += 512) ((LAS unsigned*)(lds + LDS_MISC))[u] = 0u;
    __syncthreads();
    XcdBarrier bar = xcd_barrier_post((unsigned*)(args.ws + WS_CTL) + 4096, (volatile LAS unsigned*)(lds + LDS_MISC) + 8);
#endif
#ifndef PROBE_DUP
#define PROBE_DUP -1
#endif
#ifndef PROBE_DRY
#define PROBE_DRY 0
#endif
#define PHASE(k) if (args.ph_lo <= (k) && (k) < args.ph_hi) { if ((k) == PROBE_DUP) { run_phase<k, PROBE_DRY>(args, lds, wave0); GRID_BAR(); } run_phase<k>(args, lds, wave0); if ((k) + 1 < args.ph_hi) GRID_BAR(); }
    PHASE(0) PHASE(1) PHASE(2) PHASE(3) PHASE(4) PHASE(5) PHASE(6) PHASE(7) PHASE(8) PHASE(9) PHASE(10) PHASE(11) PHASE(12)
    PHASE(13) PHASE(14) PHASE(15) PHASE(16) PHASE(17) PHASE(18) PHASE(19) PHASE(20) PHASE(21) PHASE(22)
    static_assert(NPHASE == 23, "phase list");
#undef PHASE
}

#ifndef CPU_EMU
}
extern "C" void kernel_launch(void* const* d_in, const int* in_sizes, int n_in, void* d_out, int out_size, void* d_ws, size_t ws_size, hipStream_t stream) {
    using namespace mk;
    static int grid = 0;
    if (grid == 0) {
        int dev = 0, cus = 0, per_cu = 0;
        if (n_in != 19 || ws_size < WS_END || out_size != ML * D) { fprintf(stderr, "kernel_launch: unexpected sizes n_in %d ws %zu (need %zu) out %d\n", n_in, ws_size, (size_t)WS_END, out_size); grid = -1; return; }
        if (hipGetDevice(&dev) != hipSuccess || hipDeviceGetAttribute(&cus, hipDeviceAttributeMultiprocessorCount, dev) != hipSuccess) { grid = -1; return; }
        if (hipFuncSetAttribute((const void*)mk_fwd, hipFuncAttributeMaxDynamicSharedMemorySize, LDS_BYTES) != hipSuccess) { fprintf(stderr, "kernel_launch: hipFuncSetAttribute failed\n"); grid = -1; return; }
        if (hipOccupancyMaxActiveBlocksPerMultiprocessor(&per_cu, (const void*)mk_fwd, 512, LDS_BYTES) != hipSuccess || per_cu < 1) { fprintf(stderr, "kernel_launch: occupancy query says %d\n", per_cu); (void)hipGetLastError(); grid = -1; return; }
        grid = cus;
    }
    if (grid < 0) return;
    (void)hipMemsetAsync((char*)d_ws + WS_CTL, 0, CTL_BYTES, stream);
    KArgs a{};
    for (int i = 0; i < 19; ++i) a.in[i] = (const float*)d_in[i];
    a.out = (float*)d_out; a.ws = (unsigned char*)d_ws; a.ph_lo = 0; a.ph_hi = NPHASE;
    void* kargs[] = {&a};
    hipError_t e = hipLaunchCooperativeKernel((const void*)mk_fwd, dim3(grid), dim3(512), kargs, LDS_BYTES, stream);
    if (e != hipSuccess) fprintf(stderr, "kernel_launch: cooperative launch failed: %s (grid %d)\n", hipGetErrorString(e), grid);
}
#else
}
#endif
```

```cpp
#ifndef CPU_EMU
#include <hip/hip_runtime.h>
#include <hip/hip_cooperative_groups.h>
#include <cstdio>
#include <cstdint>
#endif
#include <cmath>

#ifndef SEQ_LEN
#define SEQ_LEN 8192
#endif
#ifndef CTX_LEN_
#define CTX_LEN_ 256
#endif
#ifndef FN1
#define FN1 64
#endif

namespace mk {
typedef unsigned short u16;
typedef unsigned int u32;
#ifndef CPU_EMU
typedef short bf16x8 __attribute__((ext_vector_type(8)));
typedef float f32x4 __attribute__((ext_vector_type(4)));
#endif
typedef unsigned u32x4 __attribute__((ext_vector_type(4)));
typedef unsigned u32x2 __attribute__((ext_vector_type(2)));

constexpr int D = 2048, NB = 2, T = SEQ_LEN, TC = CTX_LEN_;
constexpr int ML = NB * T, MC = NB * TC, M = ML + MC;
constexpr int FGW = 256, MH = 8, DV = 128, DK = 64, NG = 32, PWP = 4352, PLD = 4096;
constexpr int NCL = T / 64, NCC = TC / 64, NCT = NCL + NCC;
constexpr int NK = 128, PH = 8, PK = 16;
constexpr int N1L = FN1, N2L = T / FN1, N1C = 16, N2C = TC / 16;
constexpr float EPS = 1e-6f;
constexpr int NLAYER = 2;
static_assert(M % 256 == 0 && ML % 256 == 0 && T % 64 == 0 && TC % 64 == 0, "row tiling");
static_assert(N1L * N2L == T && N1C * N2C == TC && N1L % 16 == 0 && N2L % 16 == 0 && N2C % 16 == 0, "dft factorisation");

constexpr size_t al(size_t x) { return (x + 4095) & ~(size_t)4095; }
constexpr size_t WS_CTL = 0, CTL_BYTES = 1u << 20;
constexpr size_t WS_MOD = WS_CTL + CTL_BYTES;
constexpr size_t WS_MODP = WS_MOD + al((size_t)2 * 3 * 12288 * 4);
constexpr size_t WS_WIN = WS_MODP + al((size_t)32 * 2 * 3 * 12288 * 4);
constexpr size_t WS_WOUT = WS_WIN + al((size_t)2 * PWP * D * 2);
constexpr size_t WS_WQ = WS_WOUT + al((size_t)2 * D * D * 2);
constexpr size_t WS_KEYS = WS_WQ + al((size_t)2 * D * D * 2);
constexpr int EROW = D * 6 / 8;
constexpr size_t WS_EU = WS_KEYS + al((size_t)2 * 8 * 2 * NK * 128 * 2);
constexpr size_t WS_EV = WS_EU + al((size_t)2 * NK * NK * EROW);
constexpr size_t WS_USC = WS_EV + al((size_t)2 * NK * NK * EROW);
constexpr size_t WS_VSC = WS_USC + al((size_t)2 * NK * NK * 4);
constexpr size_t WS_XS = WS_VSC + al((size_t)2 * NK * NK * 4);
constexpr size_t WS_H = WS_XS + al((size_t)M * D * 4);
constexpr size_t WS_P = WS_H + al((size_t)M * D * 2);
constexpr size_t WS_GATES = WS_P + al((size_t)M * PLD * 2);
constexpr size_t WS_QKC = WS_GATES + al((size_t)M * NG * 4);
constexpr size_t WS_Y = WS_QKC + al((size_t)M * 1024 * 2);
constexpr size_t WS_CCH = WS_Y + al((size_t)M * D * 2);
constexpr size_t WS_CPV = WS_CCH + al((size_t)2 * 16 * NCT * 8192 * 2);
constexpr size_t WS_NCH = WS_CPV + al((size_t)2 * 16 * NCT * 8192 * 2);
constexpr size_t WS_NPV = WS_NCH + al((size_t)2 * 16 * NCT * 64 * 4);
constexpr size_t WS_MLOC = WS_NPV + al((size_t)2 * 16 * NCT * 64 * 4);
constexpr size_t WS_BEND = WS_MLOC + al((size_t)2 * 16 * NCT * 4);
constexpr size_t WS_MPV = WS_BEND + al((size_t)2 * 16 * NCT * 4);
constexpr size_t WS_GAL = WS_MPV + al((size_t)2 * 16 * NCT * 4);
constexpr size_t WS_GAC = WS_GAL + al((size_t)NB * 4 * T * 288 * 2);
constexpr size_t WS_WR = WS_GAC + al((size_t)NB * 4 * TC * 288 * 2);
constexpr size_t WS_IDX = WS_WR + al((size_t)M * 576 * 4);
constexpr size_t WS_GW = WS_IDX + al((size_t)M * 128 * 4);
constexpr size_t WS_MQ = WS_GW + al((size_t)M * 128 * 4);
constexpr size_t WS_END = WS_MQ + al((size_t)256 * 256 * 2);
constexpr size_t WS_QP = WS_P;
static_assert(SEQ_LEN != 8192 || WS_END <= (size_t)1073741824, "workspace map exceeds 1 GiB");

__device__ __forceinline__ float bf2f(u32 h) { u32 u = h << 16; float f; __builtin_memcpy(&f, &u, 4); return f; }
#ifdef CPU_EMU
__device__ __forceinline__ u32 f2bf(float f) { u32 u; __builtin_memcpy(&u, &f, 4); return (u + 0x7fffu + ((u >> 16) & 1u)) >> 16; }
#else
__device__ __forceinline__ u32 f2bf(float f) { return (u32)__builtin_bit_cast(unsigned short, (__bf16)f); }
#endif
#ifdef CPU_EMU
__device__ __forceinline__ u32 pk2(float lo, float hi) { return f2bf(lo) | (f2bf(hi) << 16); }
#else
typedef __bf16 bf16x2_t_ __attribute__((ext_vector_type(2)));
typedef float f32x2_t_ __attribute__((ext_vector_type(2)));
__device__ __forceinline__ u32 pk2(float lo, float hi) { return __builtin_bit_cast(u32, __builtin_convertvector((f32x2_t_){lo, hi}, bf16x2_t_)); }
#endif
__device__ __forceinline__ float lo16(u32 w) { u32 u = w << 16; float f; __builtin_memcpy(&f, &u, 4); return f; }
__device__ __forceinline__ float hi16(u32 w) { u32 u = w & 0xffff0000u; float f; __builtin_memcpy(&f, &u, 4); return f; }
__device__ __forceinline__ u32 fbits(float f) { u32 u; __builtin_memcpy(&u, &f, 4); return u; }
__device__ __forceinline__ float bitsf(u32 u) { float f; __builtin_memcpy(&f, &u, 4); return f; }
#ifdef CPU_EMU
__device__ __forceinline__ float fexp(float x) { return expf(x); }
__device__ __forceinline__ float frcp(float x) { return 1.0f / x; }
__device__ __forceinline__ float frsq(float x) { return 1.0f / sqrtf(x); }
#else
__device__ __forceinline__ float fexp(float x) { return __builtin_amdgcn_exp2f(x * 1.4426950408889634f); }
__device__ __forceinline__ float frcp(float x) { return __builtin_amdgcn_rcpf(x); }
__device__ __forceinline__ float frsq(float x) { return __builtin_amdgcn_rsqf(x); }
#endif
#ifdef CPU_EMU
__device__ __forceinline__ float cos_rev(float x) { return cosf(6.283185307179586f * x); }
__device__ __forceinline__ float sin_rev(float x) { return sinf(6.283185307179586f * x); }
#else
__device__ __forceinline__ float cos_rev(float x) { return __builtin_amdgcn_cosf(x); }
__device__ __forceinline__ float sin_rev(float x) { return __builtin_amdgcn_sinf(x); }
#endif
__device__ __forceinline__ float sigmoidf_(float x) { return frcp(1.0f + fexp(-x)); }
__device__ __forceinline__ float siluf_(float x) { return x * frcp(1.0f + fexp(-x)); }
__device__ __forceinline__ float logsigf_(float x) { return x < 0.f ? x - log1pf(expf(x)) : -log1pf(expf(-x)); }
__device__ __forceinline__ float geluf_(float x) { return 0.5f * x * (1.0f + tanhf(0.7978845608028654f * (x + 0.044715f * x * x * x))); }
typedef unsigned u32x6 __attribute__((ext_vector_type(6)));
__device__ __forceinline__ u32 f2e2m3(float x) {
    const u32 sgn = (fbits(x) >> 31) << 5; const float a = fabsf(x); u32 code;
    if (a >= 7.5f) code = 31u;
    else if (a < 2.0f) code = (u32)(int)rintf(a * 8.0f);
    else if (a < 4.0f) code = (u32)(int)rintf(a * 4.0f) + 8u;
    else { code = (u32)(int)rintf(a * 2.0f) + 16u; if (code > 31u) code = 31u; }
    return sgn | code;
}
#ifndef CPU_EMU
typedef float f32x16_ __attribute__((ext_vector_type(16)));
__device__ __forceinline__ u32x6 fp6_enc32(const float* v) {
    f32x16_ x, y;
#pragma unroll
    for (int i = 0; i < 16; ++i) { x[i] = v[2 * i]; y[i] = v[2 * i + 1]; }
    return __builtin_amdgcn_cvt_scalef32_2xpk16_fp6_f32(x, y, 1.0f);
}
__device__ __forceinline__ u32x6 fp6_enc32_sw(const float* v) {
#else
__device__ __forceinline__ u32x6 fp6_enc32(const float* v) {
#endif
    u32 w[6] = {0u, 0u, 0u, 0u, 0u, 0u};
#pragma unroll
    for (int i = 0; i < 32; ++i) { const u32 cd = f2e2m3(v[i]); const int bit = 6 * i, d = bit >> 5, sh = bit & 31; w[d] |= cd << sh; if (sh > 26) w[d + 1] |= cd >> (32 - sh); }
    return (u32x6){w[0], w[1], w[2], w[3], w[4], w[5]};
}
#ifdef CPU_EMU
__device__ __forceinline__ float e2m32f(u32 c) { const u32 e = (c >> 3) & 3u, m = c & 7u; const float v = e == 0 ? (float)m * 0.125f : (1.0f + (float)m * 0.125f) * (float)(1u << (e - 1)); return (c & 32u) ? -v : v; }
__device__ __forceinline__ void fp6_dec32(const u32x6& p, float* o) {
    const u32 w[6] = {p[0], p[1], p[2], p[3], p[4], p[5]};
    for (int i = 0; i < 32; ++i) { const int bit = 6 * i, d = bit >> 5, sh = bit & 31; u32 c = w[d] >> sh; if (sh > 26) c |= w[d + 1] << (32 - sh); o[i] = e2m32f(c & 63u); }
}
#else
typedef float f32x32_ __attribute__((ext_vector_type(32)));
__device__ __forceinline__ void fp6_dec32(const u32x6& p, float* o) {
    const f32x32_ f = __builtin_amdgcn_cvt_scalef32_pk32_f32_fp6(p, 1.0f);
#pragma unroll
    for (int i = 0; i < 32; ++i) o[i] = f[i];
}
#endif
#ifdef CPU_EMU
__device__ __forceinline__ void fp6_dec32_bf16(const u32x6& p, u32* o) { float f[32]; fp6_dec32(p, f); for (int i = 0; i < 16; ++i) o[i] = pk2(f[2 * i], f[2 * i + 1]); }
#else
typedef __bf16 bf16x32_ __attribute__((ext_vector_type(32)));
typedef unsigned u32x16_ __attribute__((ext_vector_type(16)));
__device__ __forceinline__ void fp6_dec32_bf16(const u32x6& p, u32* o) {
    const u32x16_ w = __builtin_bit_cast(u32x16_, __builtin_amdgcn_cvt_scalef32_pk32_bf16_fp6(p, 1.0f));
#pragma unroll
    for (int i = 0; i < 16; ++i) o[i] = w[i];
}
#endif
#ifdef CPU_EMU
__device__ __forceinline__ float lane_xor1(float v) { return __shfl_xor(v, 1); }
__device__ __forceinline__ float lane_xor2(float v) { return __shfl_xor(v, 2); }
__device__ __forceinline__ float sum_lanebits_2_5(float v) { v += __shfl_xor(v, 4); v += __shfl_xor(v, 8); v += __shfl_xor(v, 16); v += __shfl_xor(v, 32); return v; }
__device__ __forceinline__ float max_lanebits_2_5(float v) { v = fmaxf(v, __shfl_xor(v, 4)); v = fmaxf(v, __shfl_xor(v, 8)); v = fmaxf(v, __shfl_xor(v, 16)); v = fmaxf(v, __shfl_xor(v, 32)); return v; }
__device__ __forceinline__ float bcast_lane_f(float v, int l) { return __shfl(v, l); }
__device__ __forceinline__ int bcast_lane_i(int v, int l) { return __shfl(v, l); }
#else
typedef unsigned u32x2_ __attribute__((ext_vector_type(2)));
#define DPP_F(v, ctrl) __builtin_bit_cast(float, __builtin_amdgcn_mov_dpp(__builtin_bit_cast(int, (v)), (ctrl), 0xF, 0xF, true))
__device__ __forceinline__ float lane_xor1(float v) { return DPP_F(v, 0xB1); }
__device__ __forceinline__ float lane_xor2(float v) { return DPP_F(v, 0x4E); }
__device__ __forceinline__ float sum_lanebits_2_5(float v) {
    v += DPP_F(v, 0x128);
    v += DPP_F(v, 0x124);
    v += __shfl_xor(v, 16); v += __shfl_xor(v, 32);
    return v;
}
__device__ __forceinline__ float max_lanebits_2_5(float v) {
    v = fmaxf(v, DPP_F(v, 0x128)); v = fmaxf(v, DPP_F(v, 0x124));
    v = fmaxf(v, __shfl_xor(v, 16)); v = fmaxf(v, __shfl_xor(v, 32));
    return v;
}
__device__ __forceinline__ float bcast_lane_f(float v, int l) { return __builtin_bit_cast(float, __builtin_amdgcn_readlane(__builtin_bit_cast(int, v), l)); }
__device__ __forceinline__ int bcast_lane_i(int v, int l) { return __builtin_amdgcn_readlane(v, l); }
#endif
__device__ __forceinline__ float wave_sum(float v) { v += lane_xor1(v); v += lane_xor2(v); return sum_lanebits_2_5(v); }
__device__ __forceinline__ float wave_max(float v) { v = fmaxf(v, lane_xor1(v)); v = fmaxf(v, lane_xor2(v)); return max_lanebits_2_5(v); }
__device__ __forceinline__ float gelu_fast(float x) { const float u2 = 1.5957691216057308f * (x + 0.044715f * x * x * x); return x / (1.0f + __expf(-u2)); }
__device__ __forceinline__ float prefix_sum_incl(float v, int lane) {
#pragma unroll
    for (int o = 1; o < 64; o <<= 1) { float t = __shfl_up(v, o); if (lane >= o) v += t; }
    return v;
}
__device__ __forceinline__ float suffix_sum_incl(float v, int lane) {
#pragma unroll
    for (int o = 1; o < 64; o <<= 1) { float t = __shfl_down(v, o); if (lane + o < 64) v += t; }
    return v;
}
__device__ __forceinline__ float prefix_max_incl(float v, int lane) {
#pragma unroll
    for (int o = 1; o < 64; o <<= 1) { float t = __shfl_up(v, o); if (lane >= o) v = fmaxf(v, t); }
    return v;
}
__device__ __forceinline__ float suffix_max_incl(float v, int lane) {
#pragma unroll
    for (int o = 1; o < 64; o <<= 1) { float t = __shfl_down(v, o); if (lane + o < 64) v = fmaxf(v, t); }
    return v;
}
__device__ __forceinline__ bf16x8 ld_frag(const u16* tile, int row0, int k0, int LD, int lane) {
    return *(const bf16x8*)(tile + (row0 + (lane & 15)) * LD + k0 + 8 * (lane >> 4));
}
#define MFMA_T(bf, af, acc) __builtin_amdgcn_mfma_f32_16x16x32_bf16((bf), (af), (acc), 0, 0, 0)
#ifndef CPU_EMU
typedef int i32x8_ __attribute__((ext_vector_type(8)));
#endif
__device__ __forceinline__ bf16x8 mk8(u32 a, u32 b, u32 c, u32 d) { return __builtin_bit_cast(bf16x8, (u32x4){a, b, c, d}); }
#ifdef CPU_EMU
#define WAVE_SYNC() emu_wave_barrier()
#else
#define WAVE_SYNC() asm volatile("s_waitcnt lgkmcnt(0)" ::: "memory")
#endif

struct KArgs { const float* in[19]; float* out; unsigned char* ws; int ph_lo, ph_hi; };
struct Ctx {
    unsigned char* lds; int tid, lane, wave, bid, G, gw, ngw;
};

namespace pg8 {
constexpr int BM = 256, BK = 64, HALF = 128, HTB = HALF * BK * 2, STAGE_BYTES = 8 * HTB, NXCD = 8, WGM = 8;
struct Unit { int pm, pn; };
struct Gemm { const u16* A; const u16* Bt; int M, N, K; };
struct StaticOrder {
    int nM, nN, nwg, G, c;
    __host__ __device__ void init(int M_, int N_, int G_, int c_) { nM = M_ / BM; nN = N_ / BM; nwg = nM * nN; G = G_; c = c_; }
    __host__ __device__ bool next(int i, Unit& u) const {
        const long L = (long)i * G + c; if (L >= nwg) return false;
        int wgid = (int)L; { const int q = nwg / NXCD, r = nwg % NXCD, xcd = wgid % NXCD, off = wgid / NXCD; wgid = (xcd < r ? xcd * (q + 1) : r * (q + 1) + (xcd - r) * q) + off; }
        const int nig = WGM * nN, gid = wgid / nig, fm = gid * WGM, gsz = (nM - fm) < WGM ? (nM - fm) : WGM;
        u.pm = fm + ((wgid % nig) % gsz); u.pn = (wgid % nig) / gsz; return true;
    }
    __device__ __forceinline__ void a_ready(const Unit&) const {}
    __device__ __forceinline__ void done(const Unit&) const {}
};
#ifndef CPU_EMU
#define PG8_LAS __attribute__((address_space(3)))
__host__ __device__ __forceinline__ int lds_byte(int r, int c) { const int st = (r >> 4) * 2 + (c >> 5), rr = r & 15, cc = c & 31, ob = rr * 64 + cc * 2; return st * 1024 + (ob ^ (((ob >> 9) & 1) << 5)); }
__host__ __device__ __forceinline__ void stage_rc(int b, int& R, int& C) { const int st = b / 1024, sb = b % 1024, swz = sb ^ (((sb >> 9) & 1) << 5); R = (st >> 1) * 16 + swz / 64; C = (st & 1) * 32 + (swz % 64) / 2; }
__host__ __device__ __forceinline__ int perm32(int rho) { const int n = rho >> 4, i = rho & 15; return 8 * (i >> 2) + 4 * n + (i & 3); }
__device__ __forceinline__ unsigned cvt_pk_bf16(float lo, float hi) { unsigned r; asm volatile("v_cvt_pk_bf16_f32 %0, %1, %2" : "=v"(r) : "v"(lo), "v"(hi)); return r; }

template <class Epi, class Sched, bool ALIGN_EPI = false, bool SP2 = false>
__device__ __forceinline__ void gemm_phase(PG8_LAS unsigned char* lds, const Gemm g, const Sched& S, const Epi& E) {
    const int tid = threadIdx.x, wid = __builtin_amdgcn_readfirstlane(tid >> 6), lane = tid & 63, wr = wid >> 2, wc = wid & 3, fr = lane & 15, fq = lane >> 4;
    const int K = g.K, nt = K / BK;
    unsigned voffA[2], voffB[2];
#pragma unroll
    for (int i = 0; i < 2; ++i) { int R, C; stage_rc(tid * 16 + i * 8192, R, C); const int Rb = Epi::PERM ? ((R & ~31) + perm32(R & 31)) : R;
        voffA[i] = (unsigned)(R * K + C) * 2u; voffB[i] = (unsigned)(Rb * K + C) * 2u; }
    const size_t kstep = (size_t)(BK * 2);
    const size_t hstep = (size_t)HALF * K * 2;
    const size_t tstep = 2 * hstep;
    const unsigned ldsw = (unsigned)wid * 1024u;
    const int aoff = lds_byte(wr * 64 + fr, fq * 8), boff = lds_byte(wc * 32 + fr, fq * 8);
#define PG8_SA(b, h) (((b) * 2 + (h)) * HTB)
#define PG8_SB(b, h) ((4 + (b) * 2 + (h)) * HTB)
#define PG8_STAGE(bufoff, gbase, voff) do { _Pragma("unroll") for (int _i = 0; _i < 2; ++_i) \
        __builtin_amdgcn_global_load_lds((const unsigned*)((const char*)(gbase) + (voff)[_i]), (PG8_LAS unsigned*)(lds + (bufoff) + ldsw + _i * 8192), 16, 0, 0); } while (0)
#define PG8_LDA(dst, b, h) do { _Pragma("unroll") for (int m = 0; m < 4; ++m) _Pragma("unroll") for (int k = 0; k < 2; ++k) dst[m][k] = *(const PG8_LAS bf16x8*)(lds + PG8_SA(b, h) + aoff + m * 2048 + k * 1024); } while (0)
#define PG8_LDB(dst, b, h) do { _Pragma("unroll") for (int n = 0; n < 2; ++n) _Pragma("unroll") for (int k = 0; k < 2; ++k) dst[n][k] = *(const PG8_LAS bf16x8*)(lds + PG8_SB(b, h) + boff + n * 2048 + k * 1024); } while (0)
#define PG8_MMA(ai, bj, At, Bt) do { __builtin_amdgcn_s_setprio(1); _Pragma("unroll") for (int m = 0; m < 4; ++m) _Pragma("unroll") for (int n = 0; n < 2; ++n) _Pragma("unroll") for (int k = 0; k < 2; ++k) \
        acc[ai][bj][m][n] = __builtin_amdgcn_mfma_f32_16x16x32_bf16(Bt[n][k], At[m][k], acc[ai][bj][m][n], 0, 0, 0); __builtin_amdgcn_s_setprio(0); } while (0)
#define PG8_WAIT_V(n) asm volatile("s_waitcnt vmcnt(" #n ")" ::: "memory")
#define PG8_WAIT_L(n) asm volatile("s_waitcnt lgkmcnt(" #n ")" ::: "memory")
#define PG8_BAR __builtin_amdgcn_s_barrier()
#define PG8_SCHED __builtin_amdgcn_sched_barrier(0)
    Unit cur, nxt; int ui = 0;
    if (!S.next(0, cur)) return;
    f32x4 acc[2][2][4][2];
#pragma unroll
    for (int a = 0; a < 2; ++a)
#pragma unroll
        for (int b = 0; b < 2; ++b)
#pragma unroll
            for (int m = 0; m < 4; ++m)
#pragma unroll
                for (int n = 0; n < 2; ++n) acc[a][b][m][n] = (f32x4){0.f, 0.f, 0.f, 0.f};
    bf16x8 At[4][2], B0[2][2], B1[2][2];
    const char* cA = (const char*)g.A + (size_t)cur.pm * tstep; const char* cB = (const char*)g.Bt + (size_t)cur.pn * tstep;
    S.a_ready(cur);
    if constexpr (SP2) {
        PG8_STAGE(PG8_SB(0, 0), cB, voffB); PG8_STAGE(PG8_SB(0, 1), cB + hstep, voffB); PG8_STAGE(PG8_SA(0, 0), cA, voffA); PG8_STAGE(PG8_SA(0, 1), cA + hstep, voffA);
        if (wr == 1) PG8_BAR;
        PG8_WAIT_V(2); PG8_BAR;
        PG8_STAGE(PG8_SB(1, 0), cB + kstep, voffB); PG8_STAGE(PG8_SA(1, 0), cA + kstep, voffA); PG8_STAGE(PG8_SB(1, 1), cB + hstep + kstep, voffB);
        PG8_WAIT_V(6); PG8_BAR;
    } else {
        PG8_STAGE(PG8_SB(0, 0), cB, voffB); PG8_STAGE(PG8_SA(0, 0), cA, voffA); PG8_STAGE(PG8_SB(0, 1), cB + hstep, voffB); PG8_STAGE(PG8_SA(0, 1), cA + hstep, voffA);
        if (wr == 1) PG8_BAR;
        PG8_WAIT_V(4); PG8_BAR;
        PG8_STAGE(PG8_SB(1, 0), cB + kstep, voffB); PG8_STAGE(PG8_SA(1, 0), cA + kstep, voffA); PG8_STAGE(PG8_SB(1, 1), cB + hstep + kstep, voffB);
        PG8_WAIT_V(6); PG8_BAR;
    }
    for (;;) {
        const bool has_next = S.next(ui + 1, nxt);
        const char* nA = has_next ? (const char*)g.A + (size_t)nxt.pm * tstep : cA; const char* nB = has_next ? (const char*)g.Bt + (size_t)nxt.pn * tstep : cB;
        for (int t = 0; t < nt; t += 2) {
            const bool last = (t == nt - 2);
            const char* a1 = cA + (size_t)(t + 1) * kstep;
            const char* a2 = last ? nA : cA + (size_t)(t + 2) * kstep; const char* b2 = last ? nB : cB + (size_t)(t + 2) * kstep;
            const char* a3 = a2 + kstep; const char* b3 = b2 + kstep;
            if (last && has_next) S.a_ready(nxt);
            if constexpr (SP2) {
            PG8_LDB(B0, 0, 0); PG8_LDB(B1, 0, 1); PG8_SCHED; PG8_LDA(At, 0, 0); PG8_STAGE(PG8_SA(1, 1), a1 + hstep, voffA);
            PG8_WAIT_V(8); PG8_WAIT_L(0); PG8_BAR; PG8_MMA(0, 0, At, B0); PG8_MMA(0, 1, At, B1); PG8_BAR; PG8_SCHED;
            PG8_LDA(At, 0, 1); PG8_STAGE(PG8_SB(0, 0), b2, voffB); PG8_STAGE(PG8_SB(0, 1), b2 + hstep, voffB); PG8_STAGE(PG8_SA(0, 0), a2, voffA);
            PG8_WAIT_V(8); PG8_WAIT_L(0); PG8_BAR; PG8_MMA(1, 0, At, B0); PG8_MMA(1, 1, At, B1); PG8_BAR; PG8_SCHED;
            PG8_LDB(B0, 1, 0); PG8_LDB(B1, 1, 1); PG8_SCHED; PG8_LDA(At, 1, 0); PG8_STAGE(PG8_SA(0, 1), a2 + hstep, voffA);
            PG8_WAIT_V(8); PG8_WAIT_L(0); PG8_BAR; PG8_MMA(0, 0, At, B0); PG8_MMA(0, 1, At, B1); PG8_BAR; PG8_SCHED;
            PG8_LDA(At, 1, 1); PG8_STAGE(PG8_SB(1, 0), b3, voffB); PG8_STAGE(PG8_SB(1, 1), b3 + hstep, voffB); PG8_STAGE(PG8_SA(1, 0), a3, voffA);
            PG8_WAIT_V(8); PG8_WAIT_L(0); PG8_BAR; PG8_MMA(1, 0, At, B0); PG8_MMA(1, 1, At, B1); PG8_BAR; PG8_SCHED;
            } else {
            PG8_LDB(B0, 0, 0); PG8_SCHED; PG8_LDA(At, 0, 0); PG8_STAGE(PG8_SA(1, 1), a1 + hstep, voffA);
            PG8_WAIT_L(8); PG8_BAR; PG8_WAIT_L(0); PG8_MMA(0, 0, At, B0); PG8_BAR; PG8_SCHED;
            PG8_LDB(B1, 0, 1); PG8_STAGE(PG8_SB(0, 0), b2, voffB);
            PG8_BAR; PG8_WAIT_L(0); PG8_MMA(0, 1, At, B1); PG8_BAR;
            PG8_LDA(At, 0, 1); PG8_STAGE(PG8_SA(0, 0), a2, voffA);
            PG8_BAR; PG8_WAIT_L(0); PG8_MMA(1, 0, At, B0); PG8_BAR; PG8_SCHED;
            PG8_STAGE(PG8_SB(0, 1), b2 + hstep, voffB);
            PG8_WAIT_V(6); PG8_BAR; PG8_MMA(1, 1, At, B1); PG8_BAR;
            PG8_LDB(B0, 1, 0); PG8_SCHED; PG8_LDA(At, 1, 0); PG8_STAGE(PG8_SA(0, 1), a2 + hstep, voffA);
            PG8_WAIT_L(8); PG8_BAR; PG8_WAIT_L(0); PG8_MMA(0, 0, At, B0); PG8_BAR; PG8_SCHED;
            PG8_LDB(B1, 1, 1); PG8_STAGE(PG8_SB(1, 0), b3, voffB);
            PG8_BAR; PG8_WAIT_L(0); PG8_MMA(0, 1, At, B1); PG8_BAR;
            PG8_LDA(At, 1, 1); PG8_STAGE(PG8_SA(1, 0), a3, voffA);
            PG8_BAR; PG8_WAIT_L(0); PG8_MMA(1, 0, At, B0); PG8_BAR; PG8_SCHED;
            PG8_STAGE(PG8_SB(1, 1), b3 + hstep, voffB);
            PG8_WAIT_V(6); PG8_BAR; PG8_MMA(1, 1, At, B1); PG8_BAR;
            }
        }
        if constexpr (ALIGN_EPI) { if (wr == 0) PG8_BAR; }
        E(acc, cur, wr, wc, fr, fq); S.done(cur);
        if (!has_next) break;
#pragma unroll
        for (int a = 0; a < 2; ++a)
#pragma unroll
            for (int b = 0; b < 2; ++b)
#pragma unroll
                for (int m = 0; m < 4; ++m)
#pragma unroll
                    for (int n = 0; n < 2; ++n) acc[a][b][m][n] = (f32x4){0.f, 0.f, 0.f, 0.f};
        cur = nxt; cA = nA; cB = nB; ++ui;
        if constexpr (ALIGN_EPI) { if (wr == 1) PG8_BAR; }
    }
    PG8_WAIT_V(0);
    if constexpr (!ALIGN_EPI) { if (wr == 0) PG8_BAR; }
    PG8_BAR;
#undef PG8_SA
#undef PG8_SB
#undef PG8_STAGE
#undef PG8_LDA
#undef PG8_LDB
#undef PG8_MMA
#undef PG8_WAIT_V
#undef PG8_WAIT_L
#undef PG8_BAR
#undef PG8_SCHED
}
#else
__device__ __forceinline__ unsigned cvt_pk_bf16(float lo, float hi) { return pk2(lo, hi); }
template <class Epi, class Sched, bool ALIGN_EPI = false, bool SP2 = false>
__device__ __forceinline__ void gemm_phase(unsigned char*, const Gemm g, const Sched& S, const Epi& E) {
    const int tid = threadIdx.x, wid = tid >> 6, lane = tid & 63, wr = wid >> 2, wc = wid & 3, fr = lane & 15, fq = lane >> 4;
    Unit u;
    for (int ui = 0; S.next(ui, u); ++ui) {
        f32x4 acc[2][2][4][2];
        for (int ai = 0; ai < 2; ++ai) for (int m = 0; m < 4; ++m) {
            const int r = 256 * u.pm + 128 * ai + 64 * wr + 16 * m + fr;
            const u16* ar = g.A + (size_t)r * g.K;
            for (int bj = 0; bj < 2; ++bj) for (int n = 0; n < 2; ++n) for (int i = 0; i < 4; ++i) {
                const int cc = 256 * u.pn + 128 * bj + 32 * wc + (Epi::PERM ? (8 * fq + 4 * n + i) : (16 * n + 4 * fq + i));
                const u16* br = g.Bt + (size_t)cc * g.K;
                float s0 = 0.f, s1 = 0.f, s2 = 0.f, s3 = 0.f;
                for (int k = 0; k < g.K; k += 4) { s0 += bf2f(ar[k]) * bf2f(br[k]); s1 += bf2f(ar[k + 1]) * bf2f(br[k + 1]); s2 += bf2f(ar[k + 2]) * bf2f(br[k + 2]); s3 += bf2f(ar[k + 3]) * bf2f(br[k + 3]); }
                acc[ai][bj][m][n][i] = (s0 + s1) + (s2 + s3);
            }
        }
        E(acc, u, wr, wc, fr, fq);
    }
    __syncthreads();
}
#endif

struct EpiInProj {
    static constexpr bool PERM = true;
    u16* P; float* gates; const float* b_gate;
    __device__ __forceinline__ void operator()(const f32x4 (&acc)[2][2][4][2], const Unit& u, int wr, int wc, int fr, int fq) const {
        const int row0 = u.pm * BM + wr * 64 + fr;
        if (u.pn < 16) {
            const int col0 = u.pn * BM + wc * 32 + 8 * fq;
#pragma unroll
            for (int ai = 0; ai < 2; ++ai)
#pragma unroll
                for (int m = 0; m < 4; ++m) { u16* rowp = P + (size_t)(row0 + ai * HALF + m * 16) * PLD + col0;
#pragma unroll
                    for (int bj = 0; bj < 2; ++bj) { const f32x4 v0 = acc[ai][bj][m][0], v1 = acc[ai][bj][m][1];
                        u32x4 w; w.x = cvt_pk_bf16(v0[0], v0[1]); w.y = cvt_pk_bf16(v0[2], v0[3]); w.z = cvt_pk_bf16(v1[0], v1[1]); w.w = cvt_pk_bf16(v1[2], v1[3]);
                        *(u32x4*)(rowp + bj * HALF) = w; } }
        } else if (wc == 0) {
            const int c0 = 8 * fq;
            float bg[8];
#pragma unroll
            for (int i = 0; i < 8; ++i) bg[i] = b_gate[c0 + i];
#pragma unroll
            for (int ai = 0; ai < 2; ++ai)
#pragma unroll
                for (int m = 0; m < 4; ++m) { float* rowp = gates + (size_t)(row0 + ai * HALF + m * 16) * NG + c0;
                    const f32x4 v0 = acc[ai][0][m][0], v1 = acc[ai][0][m][1];
                    *(f32x4*)(rowp) = (f32x4){v0[0] + bg[0], v0[1] + bg[1], v0[2] + bg[2], v0[3] + bg[3]};
                    *(f32x4*)(rowp + 4) = (f32x4){v1[0] + bg[4], v1[1] + bg[5], v1[2] + bg[6], v1[3] + bg[7]}; }
        }
    }
};
struct EpiBf16 {
    static constexpr bool PERM = true;
    u16* O; int ldc;
    __device__ __forceinline__ void operator()(const f32x4 (&acc)[2][2][4][2], const Unit& u, int wr, int wc, int fr, int fq) const {
        const int row0 = u.pm * BM + wr * 64 + fr, col0 = u.pn * BM + wc * 32 + 8 * fq;
#pragma unroll
        for (int ai = 0; ai < 2; ++ai)
#pragma unroll
            for (int m = 0; m < 4; ++m) { u16* rowp = O + (size_t)(row0 + ai * HALF + m * 16) * ldc + col0;
#pragma unroll
                for (int bj = 0; bj < 2; ++bj) { const f32x4 v0 = acc[ai][bj][m][0], v1 = acc[ai][bj][m][1];
                    u32x4 w; w.x = cvt_pk_bf16(v0[0], v0[1]); w.y = cvt_pk_bf16(v0[2], v0[3]); w.z = cvt_pk_bf16(v1[0], v1[1]); w.w = cvt_pk_bf16(v1[2], v1[3]);
                    *(u32x4*)(rowp + bj * HALF) = w; } }
    }
};
struct EpiResid {
    static constexpr bool PERM = false;
    const float* xl; const float* xc; float* XS; const float* ga;
    __device__ __forceinline__ void operator()(const f32x4 (&acc)[2][2][4][2], const Unit& u, int wr, int wc, int fr, int fq) const {
        const int row0 = u.pm * BM + wr * 64 + fr, col0 = u.pn * BM + wc * 32 + 4 * fq;
#pragma unroll
        for (int ai = 0; ai < 2; ++ai)
#pragma unroll
            for (int m = 0; m < 4; ++m) {
                const int row = row0 + ai * HALF + m * 16;
                const int mi = row < ML ? (row / T) : 2;
                const float* bp = row < ML ? xl + (size_t)row * D : xc + (size_t)(row - ML) * D;
                const float* gp = ga + (size_t)mi * 12288;
#pragma unroll
                for (int bj = 0; bj < 2; ++bj)
#pragma unroll
                    for (int n = 0; n < 2; ++n) { const int c = col0 + bj * HALF + n * 16;
                        const f32x4 b4 = *(const f32x4*)(bp + c), g4 = *(const f32x4*)(gp + c);
                        *(f32x4*)(XS + (size_t)row * D + c) = b4 + g4 * acc[ai][bj][m][n]; }
            }
    }
};
template <bool IN_BF16> struct EpiResidB {
    static constexpr bool PERM = true;
    const void* xl; const void* xc; u16* XS; const float* ga;
    __device__ __forceinline__ void operator()(const f32x4 (&acc)[2][2][4][2], const Unit& u, int wr, int wc, int fr, int fq) const {
        const int row0 = u.pm * BM + wr * 64 + fr, col0 = u.pn * BM + wc * 32 + 8 * fq;
#pragma unroll
        for (int ai = 0; ai < 2; ++ai)
#pragma unroll
            for (int m = 0; m < 4; ++m) {
                const int row = row0 + ai * HALF + m * 16;
                const int mi = row < ML ? (row / T) : 2;
                const float* gp = ga + (size_t)mi * 12288;
#pragma unroll
                for (int bj = 0; bj < 2; ++bj) { const int c = col0 + bj * HALF;
                    const f32x4 v0 = acc[ai][bj][m][0], v1 = acc[ai][bj][m][1];
                    const f32x4 g0 = *(const f32x4*)(gp + c), g1 = *(const f32x4*)(gp + c + 4);
                    f32x4 b0, b1;
                    if constexpr (IN_BF16) { const u16* bp = row < ML ? (const u16*)xl + (size_t)row * D : (const u16*)xc + (size_t)(row - ML) * D;
                        const u32x4 r = *(const u32x4*)(bp + c);
                        b0 = (f32x4){lo16(r.x), hi16(r.x), lo16(r.y), hi16(r.y)}; b1 = (f32x4){lo16(r.z), hi16(r.z), lo16(r.w), hi16(r.w)};
                    } else { const float* bp = row < ML ? (const float*)xl + (size_t)row * D : (const float*)xc + (size_t)(row - ML) * D;
                        b0 = *(const f32x4*)(bp + c); b1 = *(const f32x4*)(bp + c + 4); }
                    const f32x4 o0 = b0 + g0 * v0, o1 = b1 + g1 * v1;
                    u32x4 w; w.x = cvt_pk_bf16(o0[0], o0[1]); w.y = cvt_pk_bf16(o0[2], o0[3]); w.z = cvt_pk_bf16(o1[0], o1[1]); w.w = cvt_pk_bf16(o1[2], o1[3]);
                    *(u32x4*)(XS + (size_t)row * D + c) = w; }
            }
    }
};
}

#ifndef CPU_EMU
#define GAS __attribute__((address_space(1)))
#define LAS __attribute__((address_space(3)))
#define XB_TMO      128
#define XB_XCNT(j)  (256  + 64 * (j))
#define XB_XSUB(j)  (1280 + 64 * (j))
#define XB_XGEN(j)  (2304 + 64 * (j))
#define XB_TOP      3328
#define XB_TOPGEN   3392
#define XCD_BAR_WORDS 3456
#define XB_SPIN_CAP (1u << 24)
__device__ __forceinline__ unsigned xb_ld(unsigned* p)              { return __hip_atomic_load(p, __ATOMIC_RELAXED, __HIP_MEMORY_SCOPE_AGENT); }
__device__ __forceinline__ unsigned xb_add(unsigned* p, unsigned v) { return __hip_atomic_fetch_add(p, v, __ATOMIC_RELAXED, __HIP_MEMORY_SCOPE_AGENT); }
__device__ __forceinline__ unsigned xb_xcc_id() { return (unsigned)__builtin_amdgcn_s_getreg((3 << 11) | 20) & 0xFu; }
#define XB_SPIN(cond, bar) do { unsigned _sp = 0; while (cond) { __builtin_amdgcn_s_sleep(1); \
    if ((++_sp & 255u) == 0u) { if (xb_ld(&(bar)[XB_TMO])) break; if (_sp > XB_SPIN_CAP) { atomicAdd(&(bar)[XB_TMO], 1u); break; } } } } while (0)
struct XcdBarrier { unsigned* bar; unsigned x; volatile LAS unsigned* st; };
__device__ __forceinline__ XcdBarrier xcd_barrier_post(unsigned* bar, volatile LAS unsigned* st) {
    XcdBarrier b; b.bar = bar; b.x = xb_xcc_id(); b.st = st;
    if (threadIdx.x == 0) (void)xb_add(&bar[XB_XCNT(b.x)], 1u);
    return b;
}
__device__ __forceinline__ void xcd_barrier_complete(unsigned* bar, unsigned x, unsigned& nloc, unsigned& nx) {
    const unsigned G = gridDim.x * gridDim.y * gridDim.z;
    unsigned sum, cnt, mine, sp = 0u;
    for (;;) {
        sum = 0u; cnt = 0u; mine = 0u;
#pragma unroll
        for (unsigned j = 0; j < 16; ++j) { const unsigned c = xb_ld(&bar[XB_XCNT(j)]); sum += c; cnt += (c > 0u) ? 1u : 0u; mine = (j == x) ? c : mine; }
        if (sum == G) break;
        __builtin_amdgcn_s_sleep(1);
        if ((++sp & 255u) == 0u) { if (xb_ld(&bar[XB_TMO])) break; if (sp > XB_SPIN_CAP) { atomicAdd(&bar[XB_TMO], 1u); break; } }
    }
    nloc = mine > 0u ? mine : 1u; nx = cnt > 0u ? cnt : 1u;
}
__device__ __forceinline__ void xcd_barrier(const XcdBarrier& b) {
    asm volatile("s_waitcnt vmcnt(0)" ::: "memory");
    __syncthreads();
    if (threadIdx.x == 0) {
        unsigned* bar = b.bar;
        __builtin_amdgcn_s_waitcnt(0);
        unsigned nloc = b.st[0], nx = b.st[1];
        if (nloc == 0u) { xcd_barrier_complete(bar, b.x, nloc, nx); b.st[0] = nloc; b.st[1] = nx; }
        const unsigned old = xb_add(&bar[XB_XSUB(b.x)], 1u);
        const unsigned gen = old / nloc;
        if (old + 1u == (gen + 1u) * nloc) {
            __builtin_amdgcn_fence(__ATOMIC_RELEASE, "agent");
            asm volatile("s_waitcnt vmcnt(0)" ::: "memory");
            const unsigned og = xb_add(&bar[XB_TOP], 1u);
            const unsigned tg = og / nx;
            if (og + 1u == (tg + 1u) * nx) xb_add(&bar[XB_TOPGEN], 1u);
            else XB_SPIN(xb_ld(&bar[XB_TOPGEN]) == tg, bar);
            __builtin_amdgcn_fence(__ATOMIC_ACQUIRE, "agent");
            xb_add(&bar[XB_XGEN(b.x)], 1u);
            asm volatile("s_waitcnt vmcnt(0)" ::: "memory");
        } else {
            XB_SPIN(xb_ld(&bar[XB_XGEN(b.x)]) == gen, bar);
            __builtin_amdgcn_fence(__ATOMIC_ACQUIRE, "agent");
            asm volatile("s_waitcnt vmcnt(0)" ::: "memory");
        }
    }
    __syncthreads();
}
#endif

constexpr int LDS_RING = 131072, LDS_MISC = LDS_RING, LDS_BYTES = 147456;

__device__ __forceinline__ int chunk_row0(int b, int cidx) { return cidx < NCC ? ML + b * TC + 64 * cidx : b * T + 64 * (cidx - NCC); }

__device__ __forceinline__ void transpose_item(const float* W, int K, int N, u16* WT, float* scr, int kb, int nb, int lane) {
    const int k0 = 64 * kb, n0 = 32 * nb;
    f32x4 v[8];
#pragma unroll
    for (int i = 0; i < 8; ++i) v[i] = *(const f32x4*)(W + (size_t)(k0 + 8 * i + (lane >> 3)) * N + n0 + 4 * (lane & 7));
#pragma unroll
    for (int i = 0; i < 8; ++i) { float* d = scr + (8 * i + (lane >> 3)) * 33 + 4 * (lane & 7); d[0] = v[i][0]; d[1] = v[i][1]; d[2] = v[i][2]; d[3] = v[i][3]; }
    WAVE_SYNC();
    const int c = lane & 7;
#pragma unroll
    for (int j = 0; j < 4; ++j) { const int n = (lane >> 3) + 8 * j; const float* s = scr + (8 * c) * 33 + n;
        u32x4 o; o.x = pk2(s[0 * 33], s[1 * 33]); o.y = pk2(s[2 * 33], s[3 * 33]); o.z = pk2(s[4 * 33], s[5 * 33]); o.w = pk2(s[6 * 33], s[7 * 33]);
        *(u32x4*)(WT + (size_t)(n0 + n) * K + k0 + 8 * c) = o; }
    WAVE_SYNC();
}
__device__ __forceinline__ void cvt8(const float* src, u16* dst) {
    const f32x4 a = *(const f32x4*)src, b = *(const f32x4*)(src + 4);
    u32x4 o; o.x = pk2(a[0], a[1]); o.y = pk2(a[2], a[3]); o.z = pk2(b[0], b[1]); o.w = pk2(b[2], b[3]);
    *(u32x4*)dst = o;
}
constexpr int CW_PQ = 8192;
constexpr int PQ_FOLD = 2 * 4 * 128, PQ_MODP = 2 * 32 * 48, PQ_TR = (2 * (97 * 32 + 2 * 64 * 32) + 3) / 4, PQ_EX = 0, PQ_MISC = 2 * 28 + 16;
constexpr int CW_EQ = 8192 + 64, EQ_ITEMS = (2 * NK * NK) / 8;
constexpr int PQ_B1 = PQ_FOLD, PQ_B2 = PQ_B1 + PQ_MODP, PQ_B3 = PQ_B2 + PQ_TR, PQ_B4 = PQ_B3 + PQ_EX, PQ_END = PQ_B4 + PQ_MISC;
__device__ __forceinline__ void gen_fold_matrix(unsigned char* ws, int bid, int G, int tid) {
    u16* MQ = (u16*)(ws + WS_MQ);
    if (tid < 256) for (int q = bid; q < 256; q += G) {
        const int ph = q <= 128 ? (tid * q) & 255 : (tid * (q - 128) - 64) & 255;
        const float v = cos_rev((float)ph / 256.0f);
        MQ[q * 256 + tid] = (u16)f2bf(q <= 128 ? v : -v);
    }
}
__device__ __forceinline__ void pro_fold_item(const KArgs& a, const Ctx& c, float* tilef, int it) {
    unsigned char* ws = a.ws;
    const int kb = it % 128, g = (it / 128) % 4, l = it / 512;
    const float* W = a.in[8] + (size_t)l * D * 4128 + (size_t)(kb * 16) * 4128 + g * 256;
    u16* tile = (u16*)tilef;
#pragma unroll
    for (int i = 0; i < 16; ++i) { const f32x4 w = *(const f32x4*)(W + (size_t)i * 4128 + c.lane * 4);
        *(u32x2*)(tile + i * 264 + c.lane * 4) = (u32x2){pk2(w[0], w[1]), pk2(w[2], w[3])}; }
    WAVE_SYNC();
    bf16x8 wf[8];
#pragma unroll
    for (int ks = 0; ks < 8; ++ks) wf[ks] = ld_frag(tile, 0, ks * 32, 264, c.lane);
    const u16* MQ = (const u16*)(ws + WS_MQ) + (c.lane & 15) * 256 + 8 * (c.lane >> 4);
    u16* o = (u16*)(ws + WS_WIN) + ((size_t)l * PWP + g * 256 + (c.lane & 15)) * D + kb * 16 + 4 * (c.lane >> 4);
#pragma unroll 2
    for (int qt = 0; qt < 16; ++qt) {
        f32x4 acc = {0.f, 0.f, 0.f, 0.f};
#pragma unroll
        for (int ks = 0; ks < 8; ++ks) acc = MFMA_T(wf[ks], *(const bf16x8*)(MQ + qt * 16 * 256 + ks * 32), acc);
        *(u32x2*)(o + (size_t)qt * 16 * D) = (u32x2){pk2(acc[0], acc[1]), pk2(acc[2], acc[3])};
    }
    WAVE_SYNC();
}
__device__ __forceinline__ void pro_modp_item(const KArgs& a, const Ctx& c, int it) {
    const float* w_mod = a.in[4]; const float* cv = a.in[1]; const float* cc = a.in[3]; float* MODP = (float*)(a.ws + WS_MODP);
    const int strip = it % 48, ks = (it / 48) % 32, l = it / (48 * 32);
    const float* W = w_mod + ((size_t)l * D + ks * 64) * 12288 + strip * 256 + c.lane * 4;
    f32x4 a0 = {0.f, 0.f, 0.f, 0.f}, a1 = a0, a2 = a0;
    const float sv0 = siluf_(cv[ks * 64 + c.lane]), sv1 = siluf_(cv[D + ks * 64 + c.lane]), sv2 = siluf_(cc[ks * 64 + c.lane]);
#pragma unroll 16
    for (int k = 0; k < 64; ++k) { const f32x4 w = *(const f32x4*)(W + (size_t)k * 12288);
        const float s0 = bcast_lane_f(sv0, k), s1 = bcast_lane_f(sv1, k), s2 = bcast_lane_f(sv2, k);
        a0 += w * s0; a1 += w * s1; a2 += w * s2; }
    float* o = MODP + ((size_t)(ks * 2 + l) * 3) * 12288 + strip * 256 + c.lane * 4;
    *(f32x4*)o = a0; *(f32x4*)(o + 12288) = a1; *(f32x4*)(o + 2 * 12288) = a2;
}
__device__ __forceinline__ void pro_tr_item(const KArgs& a, const Ctx& c, float* scr, int it) {
    unsigned char* ws = a.ws;
    constexpr int NBI = 97 * 32, NBO = 64 * 32;
    int r = it; const int l = r / (NBI + 2 * NBO); r -= l * (NBI + 2 * NBO);
    if (l >= 2) return;
    if (r < NBI) { transpose_item(a.in[8] + (size_t)l * D * 4128, D, 4128, (u16*)(ws + WS_WIN) + (size_t)l * PWP * D, scr, r / 97, 32 + r % 97, c.lane); }
    else if (r < NBI + NBO) { r -= NBI; transpose_item(a.in[13] + (size_t)l * D * D, D, D, (u16*)(ws + WS_WOUT) + (size_t)l * D * D, scr, r / 64, r % 64, c.lane); }
    else { r -= NBI + NBO; transpose_item(a.in[14] + (size_t)l * D * D, D, D, (u16*)(ws + WS_WQ) + (size_t)l * D * D, scr, r / 64, r % 64, c.lane); }
}
__device__ __forceinline__ void pro_expert_load(const KArgs& a, const Ctx& c, int r, float (&v)[32]) {
    const int tb = r / (2 * NK * NK), row = r % (2 * NK * NK);
    const float* src = (tb ? a.in[17] : a.in[16]) + (size_t)row * D + 4 * c.lane;
#pragma unroll
    for (int q = 0; q < 8; ++q) { const f32x4 t = *(const f32x4*)(src + 256 * q);
#pragma unroll
        for (int k = 0; k < 4; ++k) v[4 * q + k] = t[k]; }
}
__device__ __forceinline__ void pro_expert_store(const KArgs& a, const Ctx& c, int r, float (&v)[32]) {
    unsigned char* ws = a.ws;
    const int tb = r / (2 * NK * NK), row = r % (2 * NK * NK);
    float mx = 0.f;
#pragma unroll
    for (int k = 0; k < 32; ++k) mx = fmaxf(mx, fabsf(v[k]));
    mx = wave_max(mx);
    const float scale = mx > 0.f ? 7.5f / mx : 1.0f, inv = mx > 0.f ? mx / 7.5f : 1.0f;
#pragma unroll
    for (int k = 0; k < 32; ++k) v[k] *= scale;
    if (!tb) {
        const u32x6 pk = fp6_enc32(v);
        u32x2* dst = (u32x2*)((unsigned char*)(ws + WS_EU) + (size_t)row * EROW + 24 * c.lane);
        dst[0] = (u32x2){pk[0], pk[1]}; dst[1] = (u32x2){pk[2], pk[3]}; dst[2] = (u32x2){pk[4], pk[5]};
    } else {
        const bool b1 = (c.lane & 16) != 0;
        float w[32];
#pragma unroll
        for (int cc = 0; cc < 4; ++cc) {
#pragma unroll
            for (int k = 0; k < 4; ++k) {
                const float send = b1 ? v[4 * cc + k] : v[16 + 4 * cc + k];
                const float recv = __shfl_xor(send, 16);
                const float own = b1 ? v[16 + 4 * cc + k] : v[4 * cc + k];
                w[8 * cc + k] = b1 ? recv : own; w[8 * cc + 4 + k] = b1 ? own : recv; } }
        const u32x6 pk = fp6_enc32(w);
        const int lp = (c.lane & 15) + 16 * (c.lane >> 5);
        unsigned char* rb = (unsigned char*)(ws + WS_EV) + (size_t)row * EROW + 16 * lp;
        if (!b1) { *(u32x4*)rb = (u32x4){pk[0], pk[1], pk[2], pk[3]}; *(u32x2*)(rb + 512) = (u32x2){pk[4], pk[5]}; }
        else { *(u32x2*)(rb + 512 + 8) = (u32x2){pk[0], pk[1]}; *(u32x4*)(rb + 1024) = (u32x4){pk[2], pk[3], pk[4], pk[5]}; }
    }
    if (c.lane == 0) ((float*)(ws + (tb ? WS_VSC : WS_USC)))[row] = inv;
}
__device__ __forceinline__ void pro_expert_row(const KArgs& a, const Ctx& c, int r) { float v[32]; pro_expert_load(a, c, r, v); pro_expert_store(a, c, r, v); }
__device__ __forceinline__ void phase_proA(const KArgs& a, const Ctx& c) {
    unsigned char* ws = a.ws;
    float* scr = (float*)(c.lds + c.wave * 16384);
    for (int t = c.gw; t < PQ_END; t += c.ngw) {
        if (t < PQ_B1) pro_fold_item(a, c, scr, t);
        else if (t < PQ_B2) pro_modp_item(a, c, t - PQ_B1);
        else if (t < PQ_B3) { for (int j = 0; j < 4; ++j) pro_tr_item(a, c, scr, (t - PQ_B2) * 4 + j); }
        else { const int m = t - PQ_B4;
            if (m < 56) {
                const int l = m / 28, r0 = (m % 28) * 8; u16* wp = (u16*)(ws + WS_WIN) + ((size_t)l * PWP + 4128 + r0) * D;
                for (int i = c.lane; i < 8 * D / 8; i += 64) *(u32x4*)(wp + (size_t)i * 8) = (u32x4){0u, 0u, 0u, 0u};
            } else {
                const int k0 = (m - 56) * 4096;
                for (int i = c.lane; i < 4096; i += 64) cvt8(a.in[15] + (size_t)(k0 + i) * 8, (u16*)(ws + WS_KEYS) + (size_t)(k0 + i) * 8); }
        }
    }
}
__device__ __forceinline__ void expert_queue(const KArgs& a, const Ctx& c, int l) {
    unsigned* qctr = (unsigned*)(a.ws + WS_CTL) + CW_EQ + 64 * l;
    volatile int* tk = (volatile int*)(c.lds);
    constexpr int NT = (2 * NK * NK) / 32;
    for (;;) {
        __syncthreads();
        if (c.tid == 0) *tk = (int)atomicAdd(qctr, 1u);
        __syncthreads();
        const int t = *tk;
        if (t >= NT) break;
        const int tb = t / (NT / 2), r0 = l * NK * NK + (t % (NT / 2)) * 32 + c.wave * 4;
        const int rb = tb * (2 * NK * NK) + r0;
        float v0[32], v1[32], v2[32], v3[32];
        pro_expert_load(a, c, rb, v0); pro_expert_load(a, c, rb + 1, v1); pro_expert_load(a, c, rb + 2, v2); pro_expert_load(a, c, rb + 3, v3);
        pro_expert_store(a, c, rb, v0); pro_expert_store(a, c, rb + 1, v1); pro_expert_store(a, c, rb + 2, v2); pro_expert_store(a, c, rb + 3, v3);
    }
}
__device__ __forceinline__ void phase_proB(const KArgs& a, const Ctx& c) {
    const float* MODP = (const float*)(a.ws + WS_MODP); float* MOD = (float*)(a.ws + WS_MOD); const float* b_mod = a.in[5];
    for (int i = c.bid * 512 + c.tid; i < 2 * 3 * 12288; i += c.G * 512) {
        const int n = i % 12288, j = (i / 12288) % 3, l = i / (3 * 12288);
        float s = b_mod[l * 12288 + n];
        for (int ks = 0; ks < 32; ++ks) s += MODP[((size_t)(ks * 2 + l) * 3 + j) * 12288 + n];
        MOD[i] = s;
    }
}
__device__ __forceinline__ void rms_mod_store(const float (&x)[32], float rstd, const float* g, const float* shift, const float* scale, u16* hrow, int lane) {
#pragma unroll
    for (int j = 0; j < 4; ++j) { const int c0 = 512 * j + 8 * lane; float y[8];
#pragma unroll
        for (int k = 0; k < 8; ++k) y[k] = x[8 * j + k] * rstd * g[c0 + k] * (1.0f + scale[c0 + k]) + shift[c0 + k];
        u32x4 o; o.x = pk2(y[0], y[1]); o.y = pk2(y[2], y[3]); o.z = pk2(y[4], y[5]); o.w = pk2(y[6], y[7]);
        *(u32x4*)(hrow + c0) = o; }
}
template <bool IN_BF16> __device__ __forceinline__ void phase_rmsmod(const KArgs& a, const Ctx& c, const void* xl_, const void* xc_, const float* g, const float* modl, int which  , int nrows) {
    u16* H = (u16*)(a.ws + WS_H);
    float gs[32], sh[32]; int cur_mi = -1;
#pragma unroll
    for (int k = 0; k < 32; ++k) { gs[k] = 0.f; sh[k] = 0.f; }
    for (int row = c.gw; row < nrows; row += 2 * c.ngw) {
        const int rowb = row + c.ngw; const bool hasb = rowb < nrows; const int rb = hasb ? rowb : row;
        float xa[32], xb[32];
        if constexpr (IN_BF16) {
            const u16* xl = (const u16*)xl_; const u16* xc = (const u16*)xc_;
            const u16* xra = row < ML ? xl + (size_t)row * D : xc + (size_t)(row - ML) * D;
            const u16* xrb = rb < ML ? xl + (size_t)rb * D : xc + (size_t)(rb - ML) * D;
            u32x4 ra[4], rbv[4];
#pragma unroll
            for (int j = 0; j < 4; ++j) ra[j] = *(const u32x4*)(xra + 512 * j + 8 * c.lane);
#pragma unroll
            for (int j = 0; j < 4; ++j) rbv[j] = *(const u32x4*)(xrb + 512 * j + 8 * c.lane);
#pragma unroll
            for (int j = 0; j < 4; ++j) {
                xa[8 * j] = lo16(ra[j].x); xa[8 * j + 1] = hi16(ra[j].x); xa[8 * j + 2] = lo16(ra[j].y); xa[8 * j + 3] = hi16(ra[j].y); xa[8 * j + 4] = lo16(ra[j].z); xa[8 * j + 5] = hi16(ra[j].z); xa[8 * j + 6] = lo16(ra[j].w); xa[8 * j + 7] = hi16(ra[j].w);
                xb[8 * j] = lo16(rbv[j].x); xb[8 * j + 1] = hi16(rbv[j].x); xb[8 * j + 2] = lo16(rbv[j].y); xb[8 * j + 3] = hi16(rbv[j].y); xb[8 * j + 4] = lo16(rbv[j].z); xb[8 * j + 5] = hi16(rbv[j].z); xb[8 * j + 6] = lo16(rbv[j].w); xb[8 * j + 7] = hi16(rbv[j].w); }
        } else {
            const float* xl = (const float*)xl_; const float* xc = (const float*)xc_;
            const float* xra = row < ML ? xl + (size_t)row * D : xc + (size_t)(row - ML) * D;
            const float* xrb = rb < ML ? xl + (size_t)rb * D : xc + (size_t)(rb - ML) * D;
#pragma unroll
            for (int j = 0; j < 4; ++j) { const f32x4 v0 = *(const f32x4*)(xra + 512 * j + 8 * c.lane), v1 = *(const f32x4*)(xra + 512 * j + 8 * c.lane + 4);
#pragma unroll
                for (int k = 0; k < 4; ++k) { xa[8 * j + k] = v0[k]; xa[8 * j + 4 + k] = v1[k]; } }
#pragma unroll
            for (int j = 0; j < 4; ++j) { const f32x4 v0 = *(const f32x4*)(xrb + 512 * j + 8 * c.lane), v1 = *(const f32x4*)(xrb + 512 * j + 8 * c.lane + 4);
#pragma unroll
                for (int k = 0; k < 4; ++k) { xb[8 * j + k] = v0[k]; xb[8 * j + 4 + k] = v1[k]; } }
        }
#pragma unroll
        for (int half = 0; half < 2; ++half) {
            if (half == 1 && !hasb) break;
            const int r = half ? rowb : row; const float (&x)[32] = half ? xb : xa;
            const int mi = r < ML ? r / T : 2;
            if (mi != cur_mi) { cur_mi = mi;
                const float* mp = modl + (size_t)mi * 12288 + which * 3 * 2048;
#pragma unroll
                for (int j = 0; j < 4; ++j) { const int c0 = 512 * j + 8 * c.lane;
#pragma unroll
                    for (int k = 0; k < 8; ++k) { gs[8 * j + k] = g[c0 + k] * (1.0f + mp[2048 + c0 + k]); sh[8 * j + k] = mp[c0 + k]; } } }
            float ss = 0.f;
#pragma unroll
            for (int k = 0; k < 32; ++k) ss += x[k] * x[k];
            ss = wave_sum(ss);
            const float rstd = 1.0f / sqrtf(ss * (1.0f / D) + EPS);
            u16* hrow = H + (size_t)r * D;
#pragma unroll
            for (int j = 0; j < 4; ++j) { float y[8];
#pragma unroll
                for (int k = 0; k < 8; ++k) y[k] = x[8 * j + k] * rstd * gs[8 * j + k] + sh[8 * j + k];
                u32x4 o; o.x = pk2(y[0], y[1]); o.y = pk2(y[2], y[3]); o.z = pk2(y[4], y[5]); o.w = pk2(y[6], y[7]);
                *(u32x4*)(hrow + 512 * j + 8 * c.lane) = o; }
        }
    }
}
__device__ __forceinline__ void conv_taps(int row, int (&trow)[9], bool (&ok)[9]) {
    if (row < ML) {
        const int b = row / T, t = row % T, r = t >> 6, w = t & 63;
#pragma unroll
        for (int i = 0; i < 3; ++i)
#pragma unroll
            for (int j = 0; j < 3; ++j) { const int rr = r + i - 1, ww = w + j - 1; const bool o = rr >= 0 && rr < T / 64 && ww >= 0 && ww < 64;
                trow[i * 3 + j] = o ? b * T + rr * 64 + ww : row; ok[i * 3 + j] = o; }
    } else {
        const int b = (row - ML) / TC, t = (row - ML) % TC;
#pragma unroll
        for (int i = 0; i < 3; ++i)
#pragma unroll
            for (int j = 0; j < 3; ++j) { const int tt = t + j - 1; const bool o = i == 1 && tt >= 0 && tt < TC;
                trow[i * 3 + j] = o ? ML + b * TC + tt : row; ok[i * 3 + j] = o; }
    }
}
__device__ __forceinline__ u32x4 conv_finish(const u32x4 (&v)[9], const bool (&ok)[9], const float (&w)[9][8], float sc) {
    float acc[8];
#pragma unroll
    for (int k = 0; k < 8; ++k) acc[k] = 0.f;
#pragma unroll
    for (int q = 0; q < 9; ++q) { const u32x4 z = ok[q] ? v[q] : (u32x4){0u, 0u, 0u, 0u};
        acc[0] += lo16(z.x) * w[q][0]; acc[1] += hi16(z.x) * w[q][1]; acc[2] += lo16(z.y) * w[q][2]; acc[3] += hi16(z.y) * w[q][3];
        acc[4] += lo16(z.z) * w[q][4]; acc[5] += hi16(z.z) * w[q][5]; acc[6] += lo16(z.w) * w[q][6]; acc[7] += hi16(z.w) * w[q][7]; }
#pragma unroll
    for (int k = 0; k < 8; ++k) acc[k] = siluf_(acc[k]) * sc;
    u32x4 o; o.x = pk2(acc[0], acc[1]); o.y = pk2(acc[2], acc[3]); o.z = pk2(acc[4], acc[5]); o.w = pk2(acc[6], acc[7]);
    return o;
}
__device__ __forceinline__ void phase_conv(const KArgs& a, const Ctx& c, int l) {
    const u16* P = (const u16*)(a.ws + WS_P); u16* QKC = (u16*)(a.ws + WS_QKC); const float* cw = a.in[10] + (size_t)l * 9 * 1024;
    const int ch0 = (c.tid & 127) * 8; const float sc = ch0 >= 512 ? 0.125f : 1.0f;
    float w[9][8];
#pragma unroll
    for (int q = 0; q < 9; ++q) { const f32x4 w0 = *(const f32x4*)(cw + q * 1024 + ch0), w1 = *(const f32x4*)(cw + q * 1024 + ch0 + 4);
        w[q][0] = w0[0]; w[q][1] = w0[1]; w[q][2] = w0[2]; w[q][3] = w0[3]; w[q][4] = w1[0]; w[q][5] = w1[1]; w[q][6] = w1[2]; w[q][7] = w1[3]; }
    const int r0 = (c.bid * 512 + c.tid) >> 7, rs = (c.G * 512) >> 7;
    for (int row = r0; row < M; row += 2 * rs) {
        const int rowb = row + rs; const bool hasb = rowb < M;
        int ta[9], tb[9]; bool oa[9], ob[9];
        conv_taps(row, ta, oa); conv_taps(hasb ? rowb : row, tb, ob);
        u32x4 va[9], vb[9];
#pragma unroll
        for (int q = 0; q < 9; ++q) va[q] = *(const u32x4*)(P + (size_t)ta[q] * PLD + 1024 + ch0);
#pragma unroll
        for (int q = 0; q < 9; ++q) vb[q] = *(const u32x4*)(P + (size_t)tb[q] * PLD + 1024 + ch0);
        *(u32x4*)(QKC + (size_t)row * 1024 + ch0) = conv_finish(va, oa, w, sc);
        if (hasb) *(u32x4*)(QKC + (size_t)rowb * 1024 + ch0) = conv_finish(vb, ob, w, sc);
    }
}
__device__ __forceinline__ void put8T(u16* tileT, int LD, int r0, int col, const u32x4& v) {
    tileT[(r0 + 0) * LD + col] = (u16)(v.x & 0xffffu); tileT[(r0 + 1) * LD + col] = (u16)(v.x >> 16);
    tileT[(r0 + 2) * LD + col] = (u16)(v.y & 0xffffu); tileT[(r0 + 3) * LD + col] = (u16)(v.y >> 16);
    tileT[(r0 + 4) * LD + col] = (u16)(v.z & 0xffffu); tileT[(r0 + 5) * LD + col] = (u16)(v.z >> 16);
    tileT[(r0 + 6) * LD + col] = (u16)(v.w & 0xffffu); tileT[(r0 + 7) * LD + col] = (u16)(v.w >> 16);
}
constexpr int S_KTF = 0, S_KTB = 9216, S_VT = 18432, S_WF = 36864, S_WB = 37120, S_END = 37376;
struct SumPre { u32x4 k, v[2]; float g0, g1, g2, g3; };
__device__ __forceinline__ void sum_prefetch(const KArgs& a, const Ctx& c, int unit, SumPre& r) {
    const int cidx = unit % NCT, bh = unit / NCT, b = bh >> 3, h = bh & 7, row0 = chunk_row0(b, cidx);
    const u16* P = (const u16*)(a.ws + WS_P); const u16* QKC = (const u16*)(a.ws + WS_QKC);
    { const int s = c.tid >> 3, g8 = c.tid & 7; r.k = *(const u32x4*)(QKC + (size_t)(row0 + s) * 1024 + 512 + h * 64 + g8 * 8); }
#pragma unroll
    for (int i = 0; i < 2; ++i) { const int it = c.tid + 512 * i, s = it >> 4, g8 = it & 15; r.v[i] = *(const u32x4*)(P + (size_t)(row0 + s) * PLD + 2048 + h * 128 + g8 * 8); }
    r.g0 = r.g1 = r.g2 = r.g3 = 0.f;
    if (c.wave == 0) { const float* gr = (const float*)(a.ws + WS_GATES) + (size_t)(row0 + c.lane) * NG; r.g0 = gr[h]; r.g1 = gr[8 + h]; r.g2 = gr[16 + h]; r.g3 = gr[24 + h]; }
}
__device__ __forceinline__ void mlstm_summary_phase(const KArgs& a, const Ctx& c) {
    unsigned char* ws = a.ws;
    u16* KTF = (u16*)(c.lds + S_KTF); u16* KTB = (u16*)(c.lds + S_KTB); u16* VT = (u16*)(c.lds + S_VT);
    float* WF = (float*)(c.lds + S_WF); float* WB = (float*)(c.lds + S_WB);
    int unit = c.bid;
    SumPre pre;
    if (unit < 16 * NCT) sum_prefetch(a, c, unit, pre);
    while (unit < 16 * NCT) {
        const int cidx = unit % NCT, bh = unit / NCT;
        const int sidx0 = (0 * 16 + bh) * NCT + cidx, sidx1 = (1 * 16 + bh) * NCT + cidx;
        if (c.wave == 0) {
            const float igf = pre.g0, lff = logsigf_(pre.g1), igb = pre.g2, lfb = logsigf_(pre.g3);
            const float bf = prefix_sum_incl(lff, c.lane), totf = __shfl(bf, 63);
            const float bb = suffix_sum_incl(lfb, c.lane), totb = __shfl(bb, 0);
            const float af = totf - bf + igf, ab = totb - bb + igb;
            const float mf = wave_max(af), mb = wave_max(ab);
            WF[c.lane] = fexp(af - mf); WB[c.lane] = fexp(ab - mb);
            if (c.lane == 0) { float* ML_ = (float*)(ws + WS_MLOC); float* BE = (float*)(ws + WS_BEND);
                ML_[sidx0] = mf; BE[sidx0] = totf; ML_[sidx1] = mb; BE[sidx1] = totb; }
        }
        const u32x4 kraw = pre.k;
#pragma unroll
        for (int i = 0; i < 2; ++i) { const int it = c.tid + 512 * i, s = it >> 4, g8 = it & 15; put8T(VT, 72, g8 * 8, s, pre.v[i]); }
        const int nxt = unit + c.G;
        if (nxt < 16 * NCT) sum_prefetch(a, c, nxt, pre);
        __syncthreads();
        { const int s = c.tid >> 3, g8 = c.tid & 7;
            const float wf = WF[s], wb = WB[s];
            const float kv[8] = {lo16(kraw.x), hi16(kraw.x), lo16(kraw.y), hi16(kraw.y), lo16(kraw.z), hi16(kraw.z), lo16(kraw.w), hi16(kraw.w)};
#pragma unroll
            for (int e = 0; e < 8; ++e) { KTF[(g8 * 8 + e) * 72 + s] = (u16)f2bf(kv[e] * wf); KTB[(g8 * 8 + e) * 72 + s] = (u16)f2bf(kv[e] * wb); } }
        __syncthreads();
        if (c.tid < 128) { const int d = c.tid >> 6, kd = c.tid & 63; const u16* KT = d ? KTB : KTF; float sum = 0.f;
#pragma unroll 4
            for (int s = 0; s < 64; ++s) sum += bf2f(KT[kd * 72 + s]);
            ((float*)(ws + WS_NCH))[(size_t)(d ? sidx1 : sidx0) * 64 + kd] = sum; }
#pragma unroll
        for (int d = 0; d < 2; ++d) { const u16* KT = d ? KTB : KTF; u16* CC = (u16*)(ws + WS_CCH) + (size_t)(d ? sidx1 : sidx0) * 8192;
#pragma unroll
            for (int kt = 0; kt < 4; ++kt) { f32x4 acc = {0.f, 0.f, 0.f, 0.f};
#pragma unroll
                for (int ks = 0; ks < 2; ++ks) acc = MFMA_T(ld_frag(KT, kt * 16, ks * 32, 72, c.lane), ld_frag(VT, c.wave * 16, ks * 32, 72, c.lane), acc);
                const int vd = c.wave * 16 + (c.lane & 15), kd = kt * 16 + 4 * (c.lane >> 4);
                u32x2 o; o.x = pk2(acc[0], acc[1]); o.y = pk2(acc[2], acc[3]);
                *(u32x2*)(CC + vd * 64 + kd) = o; } }
        __syncthreads();
        unit = nxt;
    }
}
constexpr int SCAN_U = 12;
static_assert(NCT % SCAN_U == 0 && (32 * 2064) % 64 == 0, "scan blocking");
__device__ __forceinline__ void scan_items(const KArgs& a, const Ctx& c) {
    unsigned char* ws = a.ws;
    const float* ML_ = (const float*)(ws + WS_MLOC); const float* BE = (const float*)(ws + WS_BEND); float* MP = (float*)(ws + WS_MPV);
    for (int wi = c.bid + c.G * c.wave; wi < 32 * 2064 / 64; wi += c.G * 8) {
        const int it = wi * 64 + c.lane;
        const int seq = it / 2064, grp = it % 2064, d = seq >> 4;
        float m = 0.f; float st[4] = {0.f, 0.f, 0.f, 0.f};
        for (int step0 = 0; step0 < NCT; step0 += SCAN_U) {
            int si[SCAN_U]; float be[SCAN_U], mc[SCAN_U]; u32x2 cb[SCAN_U]; f32x4 cn[SCAN_U];
#pragma unroll
            for (int u = 0; u < SCAN_U; ++u) { const int step = step0 + u;
                const int cidx = d == 0 ? step : (step < NCC ? NCC - 1 - step : NCT - 1 - (step - NCC));
                si[u] = seq * NCT + cidx; be[u] = BE[si[u]]; mc[u] = ML_[si[u]];
                if (grp < 2048) cb[u] = *(const u32x2*)((const u16*)(ws + WS_CCH) + (size_t)si[u] * 8192 + grp * 4);
                else cn[u] = *(const f32x4*)((const float*)(ws + WS_NCH) + (size_t)si[u] * 64 + (grp - 2048) * 4); }
#pragma unroll
            for (int u = 0; u < SCAN_U; ++u) {
                const float mn = fmaxf(be[u] + m, mc[u]), fo = fexp(be[u] + m - mn), fn = fexp(mc[u] - mn);
                if (grp < 2048) {
                    u32x2 o; o.x = pk2(st[0], st[1]); o.y = pk2(st[2], st[3]);
                    *(u32x2*)((u16*)(ws + WS_CPV) + (size_t)si[u] * 8192 + grp * 4) = o;
                    st[0] = fo * st[0] + fn * lo16(cb[u].x); st[1] = fo * st[1] + fn * hi16(cb[u].x); st[2] = fo * st[2] + fn * lo16(cb[u].y); st[3] = fo * st[3] + fn * hi16(cb[u].y);
                } else {
                    *(f32x4*)((float*)(ws + WS_NPV) + (size_t)si[u] * 64 + (grp - 2048) * 4) = (f32x4){st[0], st[1], st[2], st[3]};
#pragma unroll
                    for (int k = 0; k < 4; ++k) st[k] = fo * st[k] + fn * cn[u][k];
                }
                if (grp == 0) MP[si[u]] = m;
                m = mn;
            }
        }
    }
}
constexpr int O_Q = 0, O_K = 9216, O_VT = 18432, O_CPF = 36864, O_CPB = 55296, O_PF = 73728, O_PB = 82944, O_F = 92160;
struct OutPre { u32x4 q, k, v[2], cpf[2], cpb[2]; u32x2 og[4]; float np, g0, g1, g2, g3, mpf, mpb; };
__device__ __forceinline__ void out_prefetch(const KArgs& a, const Ctx& c, int unit, OutPre& r) {
    unsigned char* ws = a.ws;
    const int cidx = unit % NCT, bh = unit / NCT, b = bh >> 3, h = bh & 7, row0 = chunk_row0(b, cidx);
    const u16* P = (const u16*)(ws + WS_P); const u16* QKC = (const u16*)(ws + WS_QKC);
    const int sidx0 = (0 * 16 + bh) * NCT + cidx, sidx1 = (1 * 16 + bh) * NCT + cidx;
    { const int s = c.tid >> 3, g8 = c.tid & 7;
        r.q = *(const u32x4*)(QKC + (size_t)(row0 + s) * 1024 + h * 64 + g8 * 8);
        r.k = *(const u32x4*)(QKC + (size_t)(row0 + s) * 1024 + 512 + h * 64 + g8 * 8); }
#pragma unroll
    for (int i = 0; i < 2; ++i) { const int it = c.tid + 512 * i;
        { const int s = it >> 4, g8 = it & 15; r.v[i] = *(const u32x4*)(P + (size_t)(row0 + s) * PLD + 2048 + h * 128 + g8 * 8); }
        { const int vd = it >> 3, g8 = it & 7;
            r.cpf[i] = *(const u32x4*)((const u16*)(ws + WS_CPV) + (size_t)sidx0 * 8192 + vd * 64 + g8 * 8);
            r.cpb[i] = *(const u32x4*)((const u16*)(ws + WS_CPV) + (size_t)sidx1 * 8192 + vd * 64 + g8 * 8); } }
#pragma unroll
    for (int jt = 0; jt < 4; ++jt) { const int j = jt * 16 + (c.lane & 15), vd = c.wave * 16 + 4 * (c.lane >> 4);
        r.og[jt] = *(const u32x2*)(P + (size_t)(row0 + j) * PLD + 3072 + h * 128 + vd); }
    r.np = 0.f;
    if (c.tid < 128) { const int d = c.tid >> 6, kd = c.tid & 63; r.np = ((const float*)(ws + WS_NPV))[(size_t)(d ? sidx1 : sidx0) * 64 + kd]; }
    r.g0 = r.g1 = r.g2 = r.g3 = r.mpf = r.mpb = 0.f;
    if (c.wave == 0) { const float* gr = (const float*)(ws + WS_GATES) + (size_t)(row0 + c.lane) * NG;
        r.g0 = gr[h]; r.g1 = gr[8 + h]; r.g2 = gr[16 + h]; r.g3 = gr[24 + h];
        r.mpf = ((const float*)(ws + WS_MPV))[sidx0]; r.mpb = ((const float*)(ws + WS_MPV))[sidx1]; }
}
__device__ __forceinline__ void mlstm_output_phase(const KArgs& a, const Ctx& c, int l, bool skip_ctx) {
    unsigned char* ws = a.ws;
    u16* Q = (u16*)(c.lds + O_Q); u16* Kt = (u16*)(c.lds + O_K); u16* VT = (u16*)(c.lds + O_VT);
    u16* CPF = (u16*)(c.lds + O_CPF); u16* CPB = (u16*)(c.lds + O_CPB); u16* PF = (u16*)(c.lds + O_PF); u16* PB = (u16*)(c.lds + O_PB);
    float* F = (float*)(c.lds + O_F);
    float *EF = F, *EB = F + 64, *RTF = F + 128, *RTB = F + 192, *INF_ = F + 256, *INB = F + 320, *MJF = F + 384, *MJB = F + 448,
          *DENF = F + 512, *DENB = F + 576, *NPF = F + 640, *NPB = F + 704, *SSQ = F + 768;
    int unit = c.bid;
    while (unit < 16 * NCT && skip_ctx && (unit % NCT) < NCC) unit += c.G;
    OutPre pre;
    if (unit < 16 * NCT) out_prefetch(a, c, unit, pre);
    while (unit < 16 * NCT) {
        const int cidx = unit % NCT, bh = unit / NCT, b = bh >> 3, h = bh & 7, row0 = chunk_row0(b, cidx);
        if (c.wave == 0) {
            const float igf = pre.g0, lff = logsigf_(pre.g1), igb = pre.g2, lfb = logsigf_(pre.g3);
            const float bf = prefix_sum_incl(lff, c.lane), bb = suffix_sum_incl(lfb, c.lane);
            const float ef = igf - bf, eb = igb - bb;
            const float pmx = prefix_max_incl(ef, c.lane), smx = suffix_max_incl(eb, c.lane);
            const float mpf = pre.mpf, mpb = pre.mpb;
            const float mjf = bf + fmaxf(mpf, pmx), mjb = bb + fmaxf(mpb, smx);
            EF[c.lane] = ef; EB[c.lane] = eb; RTF[c.lane] = bf - mjf; RTB[c.lane] = bb - mjb;
            INF_[c.lane] = fexp(bf - mjf + mpf); INB[c.lane] = fexp(bb - mjb + mpb); MJF[c.lane] = mjf; MJB[c.lane] = mjb;
        }
        { const int s = c.tid >> 3, g8 = c.tid & 7; *(u32x4*)(Q + s * 72 + g8 * 8) = pre.q; *(u32x4*)(Kt + s * 72 + g8 * 8) = pre.k; }
#pragma unroll
        for (int i = 0; i < 2; ++i) { const int it = c.tid + 512 * i;
            { const int s = it >> 4, g8 = it & 15; put8T(VT, 72, g8 * 8, s, pre.v[i]); }
            { const int vd = it >> 3, g8 = it & 7; *(u32x4*)(CPF + vd * 72 + g8 * 8) = pre.cpf[i]; *(u32x4*)(CPB + vd * 72 + g8 * 8) = pre.cpb[i]; } }
        if (c.tid < 128) { const int d = c.tid >> 6, kd = c.tid & 63; (d ? NPB : NPF)[kd] = pre.np; }
        u32x2 og[4];
#pragma unroll
        for (int jt = 0; jt < 4; ++jt) og[jt] = pre.og[jt];
        int nxt = unit + c.G;
        while (nxt < 16 * NCT && skip_ctx && (nxt % NCT) < NCC) nxt += c.G;
        if (nxt < 16 * NCT) out_prefetch(a, c, nxt, pre);
        __syncthreads();
        { const int jt = c.wave >> 1;
#pragma unroll
            for (int t2 = 0; t2 < 2; ++t2) { const int st = 2 * (c.wave & 1) + t2; f32x4 acc = {0.f, 0.f, 0.f, 0.f};
#pragma unroll
                for (int ks = 0; ks < 2; ++ks) acc = MFMA_T(ld_frag(Kt, st * 16, ks * 32, 72, c.lane), ld_frag(Q, jt * 16, ks * 32, 72, c.lane), acc);
                const int j = jt * 16 + (c.lane & 15), s0 = st * 16 + 4 * (c.lane >> 4);
                const float rf = RTF[j], rb = RTB[j]; float pf[4], pb[4];
#pragma unroll
                for (int i = 0; i < 4; ++i) { const int s_ = s0 + i;
                    pf[i] = s_ <= j ? acc[i] * fexp(rf + EF[s_]) : 0.f; pb[i] = s_ >= j ? acc[i] * fexp(rb + EB[s_]) : 0.f; }
                u32x2 o; o.x = pk2(pf[0], pf[1]); o.y = pk2(pf[2], pf[3]); *(u32x2*)(PF + j * 72 + s0) = o;
                o.x = pk2(pb[0], pb[1]); o.y = pk2(pb[2], pb[3]); *(u32x2*)(PB + j * 72 + s0) = o; } }
        __syncthreads();
        {
            const int pr = c.tid >> 2, kq = c.tid & 3, d = pr >> 6, j = pr & 63; const u16* Px = d ? PB : PF; const float* NP = d ? NPB : NPF; float qn = 0.f, ps = 0.f;
            const u32x4* qp = (const u32x4*)(Q + j * 72 + 16 * kq); const u32x4* pp = (const u32x4*)(Px + j * 72 + 16 * kq); const f32x4* np4 = (const f32x4*)(NP + 16 * kq);
#pragma unroll
            for (int h8 = 0; h8 < 2; ++h8) { const u32x4 qv = qp[h8], pv = pp[h8]; const f32x4 n0 = np4[2 * h8], n1 = np4[2 * h8 + 1];
                qn += lo16(qv.x) * n0[0] + hi16(qv.x) * n0[1] + lo16(qv.y) * n0[2] + hi16(qv.y) * n0[3] + lo16(qv.z) * n1[0] + hi16(qv.z) * n1[1] + lo16(qv.w) * n1[2] + hi16(qv.w) * n1[3];
                ps += (lo16(pv.x) + hi16(pv.x)) + (lo16(pv.y) + hi16(pv.y)) + (lo16(pv.z) + hi16(pv.z)) + (lo16(pv.w) + hi16(pv.w)); }
            qn += lane_xor1(qn); qn += lane_xor2(qn); ps += lane_xor1(ps); ps += lane_xor2(ps);
            if (kq == 0) (d ? DENB : DENF)[j] = (d ? INB : INF_)[j] * qn + ps; }
        f32x4 hacc[2][4];
#pragma unroll
        for (int d = 0; d < 2; ++d) { const u16* CP = d ? CPB : CPF; const u16* Px = d ? PB : PF; const float* IN = d ? INB : INF_;
#pragma unroll
            for (int jt = 0; jt < 4; ++jt) { f32x4 acc = {0.f, 0.f, 0.f, 0.f};
#pragma unroll
                for (int ks = 0; ks < 2; ++ks) acc = MFMA_T(ld_frag(CP, c.wave * 16, ks * 32, 72, c.lane), ld_frag(Q, jt * 16, ks * 32, 72, c.lane), acc);
                acc = acc * IN[jt * 16 + (c.lane & 15)];
#pragma unroll
                for (int ks = 0; ks < 2; ++ks) acc = MFMA_T(ld_frag(VT, c.wave * 16, ks * 32, 72, c.lane), ld_frag(Px, jt * 16, ks * 32, 72, c.lane), acc);
                hacc[d][jt] = acc; } }
        __syncthreads();
        f32x4 hv[4];
#pragma unroll
        for (int jt = 0; jt < 4; ++jt) { const int j = jt * 16 + (c.lane & 15);
            const float df = fmaxf(fabsf(DENF[j]), fexp(-MJF[j])), db = fmaxf(fabsf(DENB[j]), fexp(-MJB[j]));
            hv[jt] = hacc[0][jt] * frcp(df) + hacc[1][jt] * frcp(db);
            float ss = hv[jt][0] * hv[jt][0] + hv[jt][1] * hv[jt][1] + hv[jt][2] * hv[jt][2] + hv[jt][3] * hv[jt][3];
            ss += __shfl_xor(ss, 16); ss += __shfl_xor(ss, 32);
            if ((c.lane >> 4) == 0) SSQ[c.wave * 64 + j] = ss; }
        __syncthreads();
        { const float* gm = a.in[12] + (size_t)l * 1024 + h * 128; u16* Y = (u16*)(ws + WS_Y);
#pragma unroll
            for (int jt = 0; jt < 4; ++jt) { const int j = jt * 16 + (c.lane & 15), vd = c.wave * 16 + 4 * (c.lane >> 4);
                float tot = 0.f;
#pragma unroll
                for (int w = 0; w < 8; ++w) tot += SSQ[w * 64 + j];
                const float rstd = frsq(tot * (1.0f / 128.0f) + EPS);
                const u32x2 ov = og[jt];
                const float ogv[4] = {lo16(ov.x), hi16(ov.x), lo16(ov.y), hi16(ov.y)}; float y[4];
#pragma unroll
                for (int i = 0; i < 4; ++i) y[i] = hv[jt][i] * rstd * gm[vd + i] * sigmoidf_(ogv[i]);
                u32x2 o; o.x = pk2(y[0], y[1]); o.y = pk2(y[2], y[3]);
                *(u32x2*)(Y + (size_t)(row0 + j) * D + 1024 + h * 128 + vd) = o; } }
        __syncthreads();
        unit = nxt;
    }
}
template <int N1> __device__ __forceinline__ void gen_FA(u16* FA, int tid) {
    constexpr int LDA = 2 * N1 + 8;
    for (int i = tid; i < 4 * N1 * N1; i += 512) { const int r = i / (2 * N1), cc = i % (2 * N1), p = r / N1, k1 = r % N1, pp = cc / N1, t1 = cc % N1;
        const float ang = (float)((k1 * t1) % N1) / (float)N1; const float cs = cos_rev(ang), sn = sin_rev(ang);
        const float v = p == 0 ? (pp == 0 ? cs : sn) : (pp == 0 ? -sn : cs);
        FA[r * LDA + cc] = (u16)f2bf(v); }
}
template <int N1, int N2> __device__ __forceinline__ void stageA_prefetch(const KArgs& a, const Ctx& c, int rowbase, int g, int t2, u32x4 (&r)[(N1 * 32 + 511) / 512]) {
    const u16* P = (const u16*)(a.ws + WS_P);
#pragma unroll
    for (int i = 0; i < (N1 * 32 + 511) / 512; ++i) { const int it = c.tid + 512 * i;
        if (it < N1 * 32) { const int t1 = it >> 5, g8 = it & 31; r[i] = *(const u32x4*)(P + (size_t)(rowbase + N2 * t1 + t2) * PLD + g * 256 + g8 * 8); } }
}
template <int N1, int N2> __device__ __forceinline__ void fourier_stageA_phase(const KArgs& a, const Ctx& c, const u16* FA, u16* XT, int rb0, u16* ga0) {
    constexpr int LDA = 2 * N1 + 8, TL = N1 * N2, NR = (N1 * 32 + 511) / 512, NU = NB * 4 * N2;
    u32x4 pre[NR];
    int v = c.bid;
    if (v < NU) stageA_prefetch<N1, N2>(a, c, rb0 + (v / (4 * N2)) * TL, (v / N2) & 3, v % N2, pre);
    for (int i = c.tid; i < 144 * LDA / 8; i += 512) *(u32x4*)(XT + i * 8) = (u32x4){0u, 0u, 0u, 0u};
    __syncthreads();
    while (v < NU) {
        const int t2 = v % N2, g = (v / N2) & 3, b = v / (4 * N2);
        u16* GA = ga0 + (size_t)b * 4 * TL * 288;
#pragma unroll
        for (int i = 0; i < NR; ++i) { const int it = c.tid + 512 * i;
            if (it < N1 * 32) { const int t1 = it >> 5, g8 = it & 31; const u32x4 vv = pre[i];
                const u32 e[8] = {vv.x & 0xffffu, vv.x >> 16, vv.y & 0xffffu, vv.y >> 16, vv.z & 0xffffu, vv.z >> 16, vv.w & 0xffffu, vv.w >> 16};
#pragma unroll
                for (int k = 0; k < 8; ++k) { const int q = g8 * 8 + k;
                    if (q <= 128) XT[q * LDA + t1] = (u16)e[k]; else XT[(q - 128) * LDA + N1 + t1] = (u16)e[k]; } } }
        const int nxt = v + c.G;
        if (nxt < NU) stageA_prefetch<N1, N2>(a, c, rb0 + (nxt / (4 * N2)) * TL, (nxt / N2) & 3, nxt % N2, pre);
        __syncthreads();
        for (int id = c.wave; id < (N1 / 16) * 9; id += 8) { const int kt = id / 9, nt = id % 9;
            f32x4 ar = {0.f, 0.f, 0.f, 0.f}, ai = ar;
#pragma unroll
            for (int ks = 0; ks < N1 / 16; ++ks) { const bf16x8 bfr = ld_frag(XT, nt * 16, ks * 32, LDA, c.lane);
                ar = MFMA_T(bfr, ld_frag(FA, kt * 16, ks * 32, LDA, c.lane), ar);
                ai = MFMA_T(bfr, ld_frag(FA, N1 + kt * 16, ks * 32, LDA, c.lane), ai); }
            const int k1 = kt * 16 + (c.lane & 15), c0 = nt * 16 + 4 * (c.lane >> 4);
            const float ang = (float)((t2 * k1) % TL) / (float)TL; const float cs = cos_rev(ang), sn = sin_rev(ang);
            const f32x4 gr = ar * cs + ai * sn, gi = ai * cs - ar * sn;
            u16* o = GA + ((((size_t)g * N1 + k1) * N2 + t2) * 2) * 144 + c0;
            u32x2 w; w.x = pk2(gr[0], gr[1]); w.y = pk2(gr[2], gr[3]); *(u32x2*)o = w;
            w.x = pk2(gi[0], gi[1]); w.y = pk2(gi[2], gi[3]); *(u32x2*)(o + 144) = w; }
        __syncthreads();
        v = nxt;
    }
}
template <int N2> __device__ __forceinline__ void gen_FB(u16* FB, int tid) {
    constexpr int LDB = 2 * N2 + 8;
    for (int i = tid; i < 2 * N2 * N2; i += 512) { const int k2 = i / (2 * N2), cc = i % (2 * N2), p = cc / N2, t2 = cc % N2;
        const float ang = (float)((k2 * t2) % N2) / (float)N2;
        FB[k2 * LDB + cc] = (u16)f2bf(p == 0 ? cos_rev(ang) : sin_rev(ang)); }
}
template <int N1, int N2> __device__ __forceinline__ void fourier_stageB_unit(const KArgs& a, const Ctx& c, const u16* FB, u16* XT2, int rowbase, const u16* GA, int g, int k1, int half) {
    constexpr int LDB = 2 * N2 + 8;
    const int c0 = half ? 80 : 0, ntl = half ? 4 : 5, ng8 = ntl * 2;
    const u16* src = GA + (((size_t)g * N1 + k1) * N2) * 288;
    for (int it = c.tid; it < N2 * 2 * ng8; it += 512) { const int g8 = it % ng8, pt = it / ng8, p = pt & 1, t2 = pt >> 1;
        const u32x4 v = *(const u32x4*)(src + (size_t)(t2 * 2 + p) * 144 + c0 + g8 * 8);
        put8T(XT2, LDB, g8 * 8, p * N2 + t2, v); }
    __syncthreads();
    float* WR = (float*)(a.ws + WS_WR);
    const float scale = 1.0f / sqrtf((float)(N1 * N2) * 256.0f);
    for (int mt = c.wave; mt < N2 / 16; mt += 8)
        for (int nl = 0; nl < ntl; ++nl) { f32x4 acc = {0.f, 0.f, 0.f, 0.f};
#pragma unroll
            for (int ks = 0; ks < N2 / 16; ++ks) acc = MFMA_T(ld_frag(XT2, nl * 16, ks * 32, LDB, c.lane), ld_frag(FB, mt * 16, ks * 32, LDB, c.lane), acc);
            const int k2 = mt * 16 + (c.lane & 15), cc = c0 + nl * 16 + 4 * (c.lane >> 4), tp = k1 + N1 * k2;
            *(f32x4*)(WR + (size_t)(rowbase + tp) * 576 + g * 144 + cc) = acc * scale; }
    __syncthreads();
}
__device__ __forceinline__ void fourier_final_item(const KArgs& a, const Ctx& c, int l, int row) {
    const int rowbase = row < ML ? (row / T) * T : ML + ((row - ML) / TC) * TC, TL = row < ML ? T : TC;
    const int tp = row - rowbase, mrow = rowbase + (TL - tp) % TL;
    const float* WR = (const float*)(a.ws + WS_WR);
    float v[4][4]; float ss[4];
#pragma unroll
    for (int g = 0; g < 4; ++g) { const float* w0 = WR + (size_t)row * 576 + g * 144; const float* w1 = WR + (size_t)mrow * 576 + g * 144;
#pragma unroll
        for (int i = 0; i < 4; ++i) { const int cc = 4 * c.lane + i; v[g][i] = cc <= 128 ? w0[cc] : w1[256 - cc]; } }
#pragma unroll
    for (int g = 0; g < 4; ++g) ss[g] = v[g][0] * v[g][0] + v[g][1] * v[g][1] + v[g][2] * v[g][2] + v[g][3] * v[g][3];
#pragma unroll
    for (int g = 0; g < 4; ++g) ss[g] = wave_sum(ss[g]);
#pragma unroll
    for (int g = 0; g < 4; ++g) { const float rstd = frsq(ss[g] * (1.0f / 256.0f) + EPS);
        const f32x4 gf = *(const f32x4*)(a.in[11] + (size_t)l * 1024 + g * 256 + 4 * c.lane);
        u32x2 o; o.x = pk2(v[g][0] * rstd * gf[0], v[g][1] * rstd * gf[1]); o.y = pk2(v[g][2] * rstd * gf[2], v[g][3] * rstd * gf[3]);
        *(u32x2*)((u16*)(a.ws + WS_Y) + (size_t)row * D + g * 256 + 4 * c.lane) = o; }
}
#define CE_DESC(a, b) do { const float _hi = fmaxf(a, b), _lo = fminf(a, b); a = _hi; b = _lo; } while (0)
__device__ __forceinline__ void bitonic_sort16_desc(float (&v)[16]) {
#pragma unroll
    for (int k = 2; k <= 16; k <<= 1)
#pragma unroll
        for (int j = k >> 1; j > 0; j >>= 1)
#pragma unroll
            for (int i = 0; i < 16; ++i) { const int p = i ^ j; if (p > i) { if ((i & k) == 0) CE_DESC(v[i], v[p]); else CE_DESC(v[p], v[i]); } }
}
__device__ __forceinline__ void bitonic_merge16_desc(float (&v)[16]) {
#pragma unroll
    for (int j = 8; j > 0; j >>= 1)
#pragma unroll
        for (int i = 0; i < 16; ++i) { const int p = i ^ j; if (p > i) CE_DESC(v[i], v[p]); }
}
__device__ __forceinline__ void merge_top16(float (&a)[16], const float (&b)[16]) {
#pragma unroll
    for (int i = 0; i < 16; ++i) a[i] = fmaxf(a[i], b[15 - i]);
    bitonic_merge16_desc(a);
}
constexpr int R_KEY = 0, R_QT = 34816, R_LST = 69632;
__device__ __forceinline__ void topk_prefetch(const KArgs& a, const Ctx& c, int l, int unit, int p, u32x4 (&kq)[4], u32x4 (&qq)[4]) {
    const int h = unit & 7, row0 = (unit >> 3) * 128;
    const u16* kp = (const u16*)(a.ws + WS_KEYS) + ((size_t)((l * 8 + h) * 2 + p)) * NK * 128; const u16* QP = (const u16*)(a.ws + WS_QP);
#pragma unroll
    for (int i = 0; i < 4; ++i) { const int it = c.tid + 512 * i, n = it >> 4, g8 = it & 15;
        kq[i] = *(const u32x4*)(kp + n * 128 + g8 * 8); qq[i] = *(const u32x4*)(QP + (size_t)(row0 + n) * D + h * 256 + p * 128 + g8 * 8); }
}
__device__ __forceinline__ void peer_topk_phase(const KArgs& a, const Ctx& c, int l, int nu) {
    unsigned char* ws = a.ws;
    u16* KEY = (u16*)(c.lds + R_KEY); u16* QT = (u16*)(c.lds + R_QT); float* LST = (float*)(c.lds + R_LST);
    const int tok = c.wave * 16 + (c.lane & 15), fq = c.lane >> 4;
    u32x4 kq[4], qq[4];
    if (c.bid < nu) topk_prefetch(a, c, l, c.bid, 0, kq, qq);
    for (int unit = c.bid; unit < nu; unit += c.G) {
    const int h = unit & 7, tb = unit >> 3, row0 = tb * 128;
    float L0[16], L1[16];
#pragma unroll
    for (int p = 0; p < 2; ++p) {
#pragma unroll
        for (int i = 0; i < 4; ++i) { const int it = c.tid + 512 * i, n = it >> 4, g8 = it & 15;
            *(u32x4*)(KEY + n * 136 + g8 * 8) = kq[i]; *(u32x4*)(QT + n * 136 + g8 * 8) = qq[i]; }
        if (p == 0) topk_prefetch(a, c, l, unit, 1, kq, qq);
        else if (unit + c.G < nu) topk_prefetch(a, c, l, unit + c.G, 0, kq, qq);
        __syncthreads();
        float va[16], vb[16];
#pragma unroll
        for (int nt = 0; nt < 8; ++nt) { f32x4 acc = {0.f, 0.f, 0.f, 0.f};
#pragma unroll
            for (int ks = 0; ks < 4; ++ks) acc = MFMA_T(ld_frag(KEY, nt * 16, ks * 32, 136, c.lane), ld_frag(QT, c.wave * 16, ks * 32, 136, c.lane), acc);
#pragma unroll
            for (int i = 0; i < 4; ++i) { const float x = bitsf((fbits(acc[i]) & ~0x7fu) | (u32)(nt * 16 + 4 * fq + i));
                if (nt < 4) va[nt * 4 + i] = x; else vb[(nt - 4) * 4 + i] = x; } }
        bitonic_sort16_desc(va); bitonic_sort16_desc(vb);
        merge_top16(va, vb);
#pragma unroll
        for (int r = 0; r < 2; ++r) {
            float ob[16];
#pragma unroll
            for (int i = 0; i < 16; ++i) ob[i] = __shfl_xor(va[i], 16 << r);
            merge_top16(va, ob); }
        if (fq == 0) {
#pragma unroll
            for (int j = 0; j < 16; j += 4) *(f32x4*)(LST + (size_t)(tok * 2 + p) * 16 + j) = (f32x4){va[j], va[j + 1], va[j + 2], va[j + 3]}; }
#pragma unroll
        for (int i = 0; i < 16; ++i) { if (p == 0) L0[i] = va[i]; else L1[i] = va[i]; }
        __syncthreads();
    }
    float Tt[16];
#pragma unroll
    for (int i = 0; i < 16; ++i) Tt[i] = -INFINITY;
#pragma unroll
    for (int rr = 0; rr < 4; ++rr) {
        float R[16];
#pragma unroll
        for (int bi = 0; bi < 16; ++bi) R[bi] = -INFINITY;
#pragma unroll
        for (int q = 0; q < 4; ++q) { if (q == fq) { const int ai = 4 * rr + q;
#pragma unroll
                for (int bi = 0; bi < 16; ++bi) if ((4 * rr + q + 1) * (bi + 1) <= 16) R[bi] = bitsf((fbits(L0[ai] + L1[bi]) & ~0xffu) | (u32)(ai * 16 + bi)); } }
        merge_top16(Tt, R);
    }
#pragma unroll
    for (int r = 0; r < 2; ++r) { float ob[16];
#pragma unroll
        for (int i = 0; i < 16; ++i) ob[i] = __shfl_xor(Tt[i], 16 << r);
        merge_top16(Tt, ob); }
    {
        float sum = 0.f; float e[16];
#pragma unroll
        for (int j = 0; j < 16; ++j) { e[j] = fexp(Tt[j] - Tt[0]); sum += e[j]; }
        const float inv = frcp(sum);
        const float* A = LST + (size_t)(tok * 2) * 16; const float* B = A + 16;
        int io[4]; float go[4];
#pragma unroll
        for (int q = 0; q < 4; ++q) if (q == fq) {
#pragma unroll
            for (int j = 0; j < 4; ++j) { const u32 pos = fbits(Tt[4 * q + j]) & 0xffu; const u32 ia = fbits(A[pos >> 4]) & 0x7fu, ib = fbits(B[pos & 15]) & 0x7fu;
                io[j] = (int)(ia * NK + ib); go[j] = e[4 * q + j] * inv; } }
        int* IDX = (int*)(ws + WS_IDX) + (size_t)(row0 + tok) * 128 + h * 16 + 4 * fq; float* GW = (float*)(ws + WS_GW) + (size_t)(row0 + tok) * 128 + h * 16 + 4 * fq;
        *(u32x4*)IDX = (u32x4){(u32)io[0], (u32)io[1], (u32)io[2], (u32)io[3]}; *(f32x4*)GW = (f32x4){go[0], go[1], go[2], go[3]};
    }
    __syncthreads();
    }
}
__device__ __forceinline__ u32x6 ld_fp6row(const unsigned char* base, int lane) {
    const u32x2* p = (const u32x2*)(base + 24 * lane); const u32x2 a = p[0], b = p[1], d = p[2];
    return (u32x6){a.x, a.y, b.x, b.y, d.x, d.y};
}
__device__ __forceinline__ u32x6 ld_fp6row_off(const unsigned char* tab, int ei, int lane) {
    const u32 off = (u32)ei * (u32)EROW + 24u * (u32)lane;
    const u32x2 a = *(const u32x2*)(tab + off), b = *(const u32x2*)(tab + off + 8u), d = *(const u32x2*)(tab + off + 16u);
    return (u32x6){a.x, a.y, b.x, b.y, d.x, d.y};
}
template <int DRY> __device__ __forceinline__ void phase_peer_gather(const KArgs& a, const Ctx& c, int l, int nrows) {
    unsigned char* ws = a.ws;
    const u16* H = (const u16*)(ws + WS_H);
    const unsigned char* EU = (const unsigned char*)(ws + WS_EU) + (size_t)l * NK * NK * EROW; const unsigned char* EV = (const unsigned char*)(ws + WS_EV) + (size_t)l * NK * NK * EROW;
    const float* USC = (const float*)(ws + WS_USC) + (size_t)l * NK * NK; const float* VSC = (const float*)(ws + WS_VSC) + (size_t)l * NK * NK;
    const int* IDX = (const int*)(ws + WS_IDX); const float* GW = (const float*)(ws + WS_GW);
    u16* XS = (u16*)(ws + WS_XS); const float* MOD = (const float*)(ws + WS_MOD);
    const bool last = l == NLAYER - 1;
    const bool hi32 = c.lane >= 32;
    const int m16 = c.lane & 15, g4 = c.lane >> 4;
    const u32 amask = ((g4 & 1) == (m16 >> 3)) ? ((m16 & 1) ? 0xffff0000u : 0x0000ffffu) : 0u;
    const int ar = (m16 & 7) >> 1;
    const u32 am0 = ar == 0 ? amask : 0u, am1 = ar == 1 ? amask : 0u, am2 = ar == 2 ? amask : 0u, am3 = ar == 3 ? amask : 0u;
    const bool dg = (m16 >> 2) == g4;
    const float dm0 = dg && (c.lane & 3) == 0 ? 1.f : 0.f, dm1 = dg && (c.lane & 3) == 1 ? 1.f : 0.f, dm2 = dg && (c.lane & 3) == 2 ? 1.f : 0.f, dm3 = dg && (c.lane & 3) == 3 ? 1.f : 0.f;
    const float dq0[4] = {4.0f * dm0, 4.0f * dm1, 4.0f * dm2, 4.0f * dm3}, dq1[4] = {0.25f * dm0, 0.25f * dm1, 0.25f * dm2, 0.25f * dm3}, dq2[4] = {dm0 / 128.0f, dm1 / 128.0f, dm2 / 128.0f, dm3 / 128.0f};
    for (int row = c.gw; row - c.wave < nrows; row += c.ngw) {
        const bool sync_ok = row - c.wave + 7 < nrows;
        if (row < nrows) {
        const int mi = row < ML ? row / T : 2;
        u32 hq[16]; f32x4 od[8];
        { const u16* hp = H + (size_t)row * D + 4 * c.lane;
#pragma unroll
            for (int q = 0; q < 8; ++q) { const u32x2 r = *(const u32x2*)(hp + 256 * q); hq[2 * q] = r.x; hq[2 * q + 1] = r.y; } }
#ifndef CPU_EMU
        i32x8_ xt0, xt1, xt2;
        {   float f[32], d[32];
#pragma unroll
            for (int i = 0; i < 16; ++i) { f[2 * i] = lo16(hq[i]) * 0.25f; f[2 * i + 1] = hi16(hq[i]) * 0.25f; }
            const u32x6 T0 = fp6_enc32(f); fp6_dec32(T0, d);
#pragma unroll
            for (int i = 0; i < 32; ++i) f[i] = (f[i] - d[i]) * 16.0f;
            const u32x6 T1 = fp6_enc32(f); fp6_dec32(T1, d);
#pragma unroll
            for (int i = 0; i < 32; ++i) f[i] = (f[i] - d[i]) * 32.0f;
            const u32x6 T2 = fp6_enc32(f);
            xt0 = (i32x8_){(int)T0[0], (int)T0[1], (int)T0[2], (int)T0[3], (int)T0[4], (int)T0[5], 0, 0};
            xt1 = (i32x8_){(int)T1[0], (int)T1[1], (int)T1[2], (int)T1[3], (int)T1[4], (int)T1[5], 0, 0};
            xt2 = (i32x8_){(int)T2[0], (int)T2[1], (int)T2[2], (int)T2[3], (int)T2[4], (int)T2[5], 0, 0}; }
#endif
#pragma unroll
        for (int q = 0; q < 8; ++q) od[q] = (f32x4){0.f, 0.f, 0.f, 0.f};
        int* off = (int*)(c.lds + 65536) + c.wave * 40; int* irow = (int*)(c.lds) + c.wave * 128; float* grow = (float*)(c.lds + 32768) + c.wave * 128;
        {   if (c.lane < 33) off[c.lane] = 0;
            WAVE_SYNC();
            int i0 = IDX[(size_t)row * 128 + c.lane], i1 = IDX[(size_t)row * 128 + 64 + c.lane];
            if (DRY == 1) { i0 &= 3; i1 &= 3; } else if (DRY == 2) { i0 &= 511; i1 &= 511; }
            const float g0 = GW[(size_t)row * 128 + c.lane], g1 = GW[(size_t)row * 128 + 64 + c.lane];
            const int r0 = i0 >> 9, r1 = i1 >> 9;
            const int q0 = atomicAdd(&off[r0 + 1], 1), q1 = atomicAdd(&off[r1 + 1], 1);
            WAVE_SYNC();
            int inc = c.lane < 32 ? off[c.lane + 1] : 0;
#pragma unroll
            for (int o = 1; o < 32; o <<= 1) { const int t = __shfl_up(inc, o); if (c.lane >= o) inc += t; }
            WAVE_SYNC();
            if (c.lane < 32) off[c.lane + 1] = inc;
            WAVE_SYNC();
            const int d0 = off[r0] + q0, d1 = off[r1] + q1;
            irow[d0] = i0; irow[d1] = i1; grow[d0] = g0; grow[d1] = g1;
            WAVE_SYNC(); }
        float* drow = (float*)(c.lds + 49152) + c.wave * 128; float* wrow = (float*)(c.lds + 57344) + c.wave * 128;
        const int si0 = irow[c.lane], si1 = irow[64 + c.lane];
        const float us0 = USC[si0], us1 = USC[si1], vs0 = VSC[si0], vs1 = VSC[si1];
#ifdef CPU_EMU
#define G_BAR() __syncthreads()
#else
#define G_BAR() __builtin_amdgcn_s_barrier()
#endif
#ifdef CPU_EMU
#define GA_DOT(U6, PART) do { u32 f[16]; fp6_dec32_bf16(U6, f); f32x4 dd = {0.f, 0.f, 0.f, 0.f}; \
            _Pragma("unroll") for (int k = 0; k < 4; ++k) dd = MFMA_T(mk8(f[4 * k], f[4 * k + 1], f[4 * k + 2], f[4 * k + 3]), mk8(hq[4 * k], hq[4 * k + 1], hq[4 * k + 2], hq[4 * k + 3]), dd); \
            PART = fmaf(dd[3], dm3, fmaf(dd[2], dm2, fmaf(dd[1], dm1, dd[0] * dm0))); } while (0)
#else
#define GA_DOT(U6, PART) do { const i32x8_ ua8_ = {(int)U6[0], (int)U6[1], (int)U6[2], (int)U6[3], (int)U6[4], (int)U6[5], 0, 0}; f32x4 dd_ = {0.f, 0.f, 0.f, 0.f}; \
            dd_ = __builtin_amdgcn_mfma_scale_f32_16x16x128_f8f6f4(ua8_, xt0, dd_, 2, 2, 0, 0x7f7f7f7f, 0, (int)0x81818181u); \
            dd_ = __builtin_amdgcn_mfma_scale_f32_16x16x128_f8f6f4(ua8_, xt1, dd_, 2, 2, 0, 0x7f7f7f7f, 0, 0x7d7d7d7d); \
            dd_ = __builtin_amdgcn_mfma_scale_f32_16x16x128_f8f6f4(ua8_, xt2, dd_, 2, 2, 0, 0x7f7f7f7f, 0, 0x78787878); \
            PART = fmaf(dd_[3], dm3, fmaf(dd_[2], dm2, fmaf(dd_[1], dm1, dd_[0] * dm0))); } while (0)
#endif
#define GA_LOAD(UR, IT) do { if ((IT) < 32) { const u32x4 ix_ = *(const u32x4*)(irow + (IT) * 4); \
            UR[0] = ld_fp6row_off(EU, (int)ix_.x, c.lane); UR[1] = ld_fp6row_off(EU, (int)ix_.y, c.lane); UR[2] = ld_fp6row_off(EU, (int)ix_.z, c.lane); UR[3] = ld_fp6row_off(EU, (int)ix_.w, c.lane); } } while (0)
#define GA_BODY(UR, IT) do { float part[4]; \
            _Pragma("unroll") for (int e = 0; e < 4; ++e) { GA_DOT(UR[e], part[e]); } \
            float p2[2], p1; \
            { const bool hi = (c.lane & 2) != 0; _Pragma("unroll") for (int k = 0; k < 2; ++k) { const float send = hi ? part[k] : part[k + 2], keep = hi ? part[k + 2] : part[k]; p2[k] = keep + lane_xor2(send); } } \
            { const bool hi = (c.lane & 1) != 0; const float send = hi ? p2[0] : p2[1], keep = hi ? p2[1] : p2[0]; p1 = keep + lane_xor1(send); } \
            p1 = sum_lanebits_2_5(p1); \
            if (c.lane < 4) drow[(IT) * 4 + c.lane] = p1; } while (0)
        {   u32x6 ua[4], ub[4];
            GA_LOAD(ua, 0);
#pragma unroll 1
            for (int it = 0; it < 32; it += 2) {
                GA_LOAD(ub, it + 1); GA_BODY(ua, it);
                GA_LOAD(ua, it + 2); GA_BODY(ub, it + 1);
                if (sync_ok && (it & 15) == 14) G_BAR();
            } }
#undef GA_LOAD
#undef GA_BODY
#undef GA_DOT
        WAVE_SYNC();
        {   const float d0 = drow[c.lane], d1 = drow[64 + c.lane];
            wrow[c.lane] = grow[c.lane] * gelu_fast(d0 * us0) * vs0; wrow[64 + c.lane] = grow[64 + c.lane] * gelu_fast(d1 * us1) * vs1; }
        WAVE_SYNC();
#define GB_LOAD(VQ, IT) do { if ((IT) < 32) { _Pragma("unroll") for (int p = 0; p < 2; ++p) { const int ei = irow[(IT) * 4 + 2 * p + (hi32 ? 1 : 0)]; \
                const u32 vo = (u32)ei * (u32)EROW + 16u * (u32)(c.lane & 31); \
                _Pragma("unroll") for (int r = 0; r < 3; ++r) VQ[p][r] = *(const u32x4*)(EV + vo + 512u * r); } } } while (0)
#define GB_BODY(VQ, IT) do { _Pragma("unroll") for (int p = 0; p < 2; ++p) { const float wsel = wrow[(IT) * 4 + 2 * p + (hi32 ? 1 : 0)]; \
                const u32 wpk = pk2(wsel, wsel); \
                const bf16x8 aw = mk8(wpk & am0, wpk & am1, wpk & am2, wpk & am3); \
                u32 f0[16], f1[16]; \
                fp6_dec32_bf16((u32x6){VQ[p][0].x, VQ[p][0].y, VQ[p][0].z, VQ[p][0].w, VQ[p][1].x, VQ[p][1].y}, f0); \
                fp6_dec32_bf16((u32x6){VQ[p][1].z, VQ[p][1].w, VQ[p][2].x, VQ[p][2].y, VQ[p][2].z, VQ[p][2].w}, f1); \
                _Pragma("unroll") for (int k = 0; k < 4; ++k) od[k] = MFMA_T(aw, mk8(f0[4 * k], f0[4 * k + 1], f0[4 * k + 2], f0[4 * k + 3]), od[k]); \
                _Pragma("unroll") for (int k = 0; k < 4; ++k) od[4 + k] = MFMA_T(aw, mk8(f1[4 * k], f1[4 * k + 1], f1[4 * k + 2], f1[4 * k + 3]), od[4 + k]); } } while (0)
        {   u32x4 va[2][3], vb[2][3];
            GB_LOAD(va, 0);
#pragma unroll 1
            for (int it = 0; it < 32; it += 2) {
                GB_LOAD(vb, it + 1); GB_BODY(va, it);
                GB_LOAD(va, it + 2); GB_BODY(vb, it + 1);
                if (sync_ok && it == 14) G_BAR();
            } }
#undef GB_LOAD
#undef GB_BODY
#undef G_BAR
        float outv[32];
#pragma unroll
        for (int q = 0; q < 8; ++q) { outv[4 * q] = od[q][0]; outv[4 * q + 1] = od[q][1]; outv[4 * q + 2] = od[q][2]; outv[4 * q + 3] = od[q][3]; }
        int row2 = row;
#ifndef CPU_EMU
        asm volatile("" : "+s"(row2));
#endif
        u16* xr = XS + (size_t)row2 * D + 4 * c.lane; const float* ga2 = MOD + ((size_t)l * 3 + mi) * 12288 + 5 * 2048 + 4 * c.lane;
        float ss = 0.f;
#pragma unroll
        for (int q = 0; q < 8; ++q) { const u32x2 xv = *(const u32x2*)(xr + 256 * q); const f32x4 v0 = {lo16(xv.x), hi16(xv.x), lo16(xv.y), hi16(xv.y)}, g0 = *(const f32x4*)(ga2 + 256 * q);
#pragma unroll
            for (int k = 0; k < 4; ++k) { const float x2 = v0[k] + g0[k] * outv[4 * q + k]; outv[4 * q + k] = x2; ss += x2 * x2; } }
        ss = wave_sum(ss);
        const float rstd = 1.0f / sqrtf(ss * (1.0f / D) + EPS);
        if (DRY != 0 && ss != 12345.678f) {   } else
        if (!last) {
            const float* mp = MOD + ((size_t)(l + 1) * 3 + mi) * 12288 + 4 * c.lane; const float* gn = a.in[6] + (size_t)(l + 1) * D + 4 * c.lane; u16* hrow = (u16*)(ws + WS_H) + (size_t)row2 * D + 4 * c.lane;
#pragma unroll
            for (int q = 0; q < 8; ++q) { float y[4];
                { u32x2 xo; xo.x = pk2(outv[4 * q], outv[4 * q + 1]); xo.y = pk2(outv[4 * q + 2], outv[4 * q + 3]); *(u32x2*)(xr + 256 * q) = xo; }
                const f32x4 g4 = *(const f32x4*)(gn + 256 * q), sh = *(const f32x4*)(mp + 256 * q), sc = *(const f32x4*)(mp + 2048 + 256 * q);
#pragma unroll
                for (int k = 0; k < 4; ++k) y[k] = outv[4 * q + k] * rstd * g4[k] * (1.0f + sc[k]) + sh[k];
                u32x2 o; o.x = pk2(y[0], y[1]); o.y = pk2(y[2], y[3]);
                *(u32x2*)(hrow + 256 * q) = o; }
        } else {
            const float* gfin = a.in[18] + 4 * c.lane; float* orow = a.out + (size_t)row2 * D + 4 * c.lane;
#pragma unroll
            for (int q = 0; q < 8; ++q) { const f32x4 g4 = *(const f32x4*)(gfin + 256 * q);
                *(f32x4*)(orow + 256 * q) = (f32x4){outv[4 * q] * rstd * g4[0], outv[4 * q + 1] * rstd * g4[1], outv[4 * q + 2] * rstd * g4[2], outv[4 * q + 3] * rstd * g4[3]}; }
        }
        }
#ifdef CPU_EMU
        __syncthreads();
#else
        __builtin_amdgcn_s_barrier();
#endif
    }
}

constexpr int NPHASE = 3 + 10 * NLAYER;
constexpr int A_FAL = 40960, A_XT = 75776, A_FAC = 114944;
constexpr int B_FBL = 0, B_FBC = 67584, B_XT2 = 69632;
static_assert(A_FAL >= S_END && A_FAL + 2 * N1L * (2 * N1L + 8) * 2 <= A_XT && A_XT + 144 * (2 * N1L + 8) * 2 <= A_FAC && A_FAC + 2 * N1C * (2 * N1C + 8) * 2 <= LDS_RING, "phase-3 LDS map");
static_assert(B_FBL + N2L * (2 * N2L + 8) * 2 <= B_FBC && B_FBC + N2C * (2 * N2C + 8) * 2 <= B_XT2 && B_XT2 + 80 * (2 * N2L + 8) * 2 <= LDS_RING && 80 * (2 * N2C + 8) * 2 <= 80 * (2 * N2L + 8) * 2, "phase-4 LDS map");

constexpr int MG_AS = 0, MG_BS = 4608;
static_assert(MC % 32 == 0, "ctx mini-GEMM tiling");
template <int MODE> __device__ __forceinline__ void mini_gemm_ctx(const KArgs& a, const Ctx& c, const u16* A  , const u16* Bt, const void* ctx_in_, const float* ga, u16* XSc  , u16* QPc) {
    const int ntiles = (MC / 32) * 16;
    for (int tile = c.bid; tile < ntiles; tile += c.G) {
        const int mt0 = tile >> 4, nt0 = tile & 15;
        u16* As = (u16*)(c.lds + MG_AS); u16* Bs = (u16*)(c.lds + MG_BS);
        const u16* Ab = A + (size_t)(mt0 * 32) * D; const u16* Bb = Bt + (size_t)(nt0 * 128) * D;
        u32x4 ra = {0u, 0u, 0u, 0u}, rb[2];
        const int ar = c.tid >> 3, ag = c.tid & 7;
        if (c.tid < 256) ra = *(const u32x4*)(Ab + (size_t)ar * D + ag * 8);
#pragma unroll
        for (int i = 0; i < 2; ++i) { const int it = c.tid + 512 * i, br = it >> 3, bg = it & 7; rb[i] = *(const u32x4*)(Bb + (size_t)br * D + bg * 8); }
        f32x4 acc[2] = {{0.f, 0.f, 0.f, 0.f}, {0.f, 0.f, 0.f, 0.f}};
        for (int kc = 0; kc < D / 64; ++kc) {
            if (c.tid < 256) *(u32x4*)(As + ar * 72 + ag * 8) = ra;
#pragma unroll
            for (int i = 0; i < 2; ++i) { const int it = c.tid + 512 * i, br = it >> 3, bg = it & 7; *(u32x4*)(Bs + br * 72 + bg * 8) = rb[i]; }
            if (kc + 1 < D / 64) { const int k0 = (kc + 1) * 64;
                if (c.tid < 256) ra = *(const u32x4*)(Ab + (size_t)ar * D + k0 + ag * 8);
#pragma unroll
                for (int i = 0; i < 2; ++i) { const int it = c.tid + 512 * i, br = it >> 3, bg = it & 7; rb[i] = *(const u32x4*)(Bb + (size_t)br * D + k0 + bg * 8); } }
            __syncthreads();
#pragma unroll
            for (int ks = 0; ks < 2; ++ks) { const bf16x8 bf = ld_frag(Bs, c.wave * 16, ks * 32, 72, c.lane);
#pragma unroll
                for (int m = 0; m < 2; ++m) acc[m] = MFMA_T(bf, ld_frag(As, m * 16, ks * 32, 72, c.lane), acc[m]); }
            __syncthreads();
        }
#pragma unroll
        for (int m = 0; m < 2; ++m) { const int r = mt0 * 32 + m * 16 + (c.lane & 15), col = nt0 * 128 + c.wave * 16 + 4 * (c.lane >> 4);
            if (MODE == 0) { const f32x4 b4 = *(const f32x4*)((const float*)ctx_in_ + (size_t)r * D + col), g4 = *(const f32x4*)(ga + col);
                const f32x4 o4 = b4 + g4 * acc[m]; u32x2 o; o.x = pk2(o4[0], o4[1]); o.y = pk2(o4[2], o4[3]); *(u32x2*)(XSc + (size_t)r * D + col) = o; }
            else { u32x2 o; o.x = pk2(acc[m][0], acc[m][1]); o.y = pk2(acc[m][2], acc[m][3]); *(u32x2*)(QPc + (size_t)r * D + col) = o; } }
    }
}
template <class E> __device__ __forceinline__ void run_gemm(unsigned char* lds, const pg8::Gemm& g, const pg8::StaticOrder& S, const E& e) {
#ifdef CPU_EMU
    pg8::gemm_phase<E, pg8::StaticOrder, true, true>(lds, g, S, e);
#else
    pg8::gemm_phase<E, pg8::StaticOrder, true, true>((PG8_LAS unsigned char*)lds, g, S, e);
#endif
}
__device__ __forceinline__ Ctx make_ctx(unsigned char* lds, int wave0) {
#ifndef CPU_EMU
    int lane = (int)__builtin_amdgcn_mbcnt_hi(~0u, __builtin_amdgcn_mbcnt_lo(~0u, 0u));
    asm volatile("" : "+v"(lane));
    const int tid = wave0 * 64 + lane;
#else
    const int tid = threadIdx.x; (void)wave0;
#endif
    Ctx c; c.lds = lds; c.tid = tid; c.lane = tid & 63; c.wave = __builtin_amdgcn_readfirstlane(tid >> 6);
    c.bid = blockIdx.x; c.G = gridDim.x; c.gw = c.bid * 8 + c.wave; c.ngw = c.G * 8;
    return c;
}
template <int PH, int DRY = 0> __device__ __forceinline__ void run_phase(const KArgs& args, unsigned char* lds, int wave0) {
    const Ctx c = make_ctx(lds, wave0);
    unsigned char* ws = args.ws;
    const float* MOD = (const float*)(ws + WS_MOD);
    if constexpr (PH == 0) phase_proA(args, c);
    else if constexpr (PH == 1) phase_proB(args, c);
    else if constexpr (PH == 2) phase_rmsmod<false>(args, c, args.in[0], args.in[2], args.in[6], MOD, 0, M);
    else {
        constexpr int l = (PH - 3) / 10, sp = (PH - 3) % 10; constexpr bool last = l == NLAYER - 1;
        const void* xl = l == 0 ? (const void*)args.in[0] : (const void*)(ws + WS_XS);
        const void* xc = l == 0 ? (const void*)args.in[2] : (const void*)((const u16*)(ws + WS_XS) + (size_t)ML * D);
        if constexpr (sp == 0) {
            pg8::Gemm g{(const u16*)(ws + WS_H), (const u16*)(ws + WS_WIN) + (size_t)l * PWP * D, M, PWP, D};
            pg8::StaticOrder S; S.init(M, PWP, c.G, c.bid);
            pg8::EpiInProj E{(u16*)(ws + WS_P), (float*)(ws + WS_GATES), args.in[9] + l * NG};
            run_gemm(lds, g, S, E);
            expert_queue(args, c, l);
        } else if constexpr (sp == 1) phase_conv(args, c, l);
        else if constexpr (sp == 2) {
            u16* FAL = (u16*)(lds + A_FAL); u16* XT = (u16*)(lds + A_XT); u16* FAC = (u16*)(lds + A_FAC);
            gen_FA<N1L>(FAL, c.tid); gen_FA<N1C>(FAC, c.tid);
            __syncthreads();
            mlstm_summary_phase(args, c);
            fourier_stageA_phase<N1L, N2L>(args, c, FAL, XT, 0, (u16*)(ws + WS_GAL));
            if (!last) fourier_stageA_phase<N1C, N2C>(args, c, FAC, XT, ML, (u16*)(ws + WS_GAC));
        } else if constexpr (sp == 3) {
            u16* FBL = (u16*)(lds + B_FBL); u16* FBC = (u16*)(lds + B_FBC); u16* XT2 = (u16*)(lds + B_XT2);
            gen_FB<N2L>(FBL, c.tid); gen_FB<N2C>(FBC, c.tid);
            __syncthreads();
            scan_items(args, c);
            constexpr int NBL = NB * 4 * N1L * 2, NBC = NB * 4 * N1C * 2;
            constexpr int ntot = NBL + (last ? 0 : NBC);
            for (int u = c.bid; u < ntot; u += c.G) {
                if (u < NBL) { const int half = u & 1, k1 = (u >> 1) % N1L, g = ((u >> 1) / N1L) & 3, b = (u >> 1) / (4 * N1L);
                    fourier_stageB_unit<N1L, N2L>(args, c, FBL, XT2, b * T, (const u16*)(ws + WS_GAL) + (size_t)b * 4 * T * 288, g, k1, half); }
                else { const int v = u - NBL, half = v & 1, k1 = (v >> 1) % N1C, g = ((v >> 1) / N1C) & 3, b = (v >> 1) / (4 * N1C);
                    fourier_stageB_unit<N1C, N2C>(args, c, FBC, XT2, ML + b * TC, (const u16*)(ws + WS_GAC) + (size_t)b * 4 * TC * 288, g, k1, half); }
            }
        } else if constexpr (sp == 4) {
            constexpr int nrows = last ? ML : M;
            mlstm_output_phase(args, c, l, last);
            for (int it = c.gw; it < nrows; it += c.ngw) fourier_final_item(args, c, l, it);
        } else if constexpr (sp == 5) {
            pg8::Gemm g{(const u16*)(ws + WS_Y), (const u16*)(ws + WS_WOUT) + (size_t)l * D * D, ML, D, D};
            pg8::StaticOrder S; S.init(ML, D, c.G, c.bid);
            pg8::EpiResidB<(l > 0)> E{xl, xc, (u16*)(ws + WS_XS), MOD + (size_t)l * 3 * 12288 + 2 * 2048};
            run_gemm(lds, g, S, E);
            if constexpr (!last) mini_gemm_ctx<0>(args, c, (const u16*)(ws + WS_Y) + (size_t)ML * D, (const u16*)(ws + WS_WOUT) + (size_t)l * D * D, xc,
                                                  MOD + ((size_t)l * 3 + 2) * 12288 + 2 * 2048, (u16*)(ws + WS_XS) + (size_t)ML * D, nullptr);
        } else if constexpr (sp == 6) phase_rmsmod<true>(args, c, (const u16*)(ws + WS_XS), (const u16*)(ws + WS_XS) + (size_t)ML * D, args.in[7] + (size_t)l * D, MOD + (size_t)l * 3 * 12288, 1, last ? ML : M);
        else if constexpr (sp == 7) {
            pg8::Gemm g{(const u16*)(ws + WS_H), (const u16*)(ws + WS_WQ) + (size_t)l * D * D, ML, D, D};
            pg8::StaticOrder S; S.init(ML, D, c.G, c.bid);
            pg8::EpiBf16 E{(u16*)(ws + WS_QP), D};
            run_gemm(lds, g, S, E);
            if constexpr (!last) mini_gemm_ctx<1>(args, c, (const u16*)(ws + WS_H) + (size_t)ML * D, (const u16*)(ws + WS_WQ) + (size_t)l * D * D, nullptr, nullptr, nullptr,
                                                  (u16*)(ws + WS_QP) + (size_t)ML * D);
        } else if constexpr (sp == 8) { constexpr int nu = ((last ? ML : M) / 128) * 8; peer_topk_phase(args, c, l, nu); }
        else phase_peer_gather<DRY>(args, c, l, last ? ML : M);
    }
}

#ifdef CPU_EMU
#define GRID_BAR() emu_grid_sync()
static void mk_fwd(KArgs args)
#else
#define GRID_BAR() xcd_barrier(bar)
__global__ void __launch_bounds__(512, 2) mk_fwd(KArgs args)
#endif
{
#ifdef CPU_EMU
    unsigned char* lds = emu_lds();
#else
    extern __shared__ __attribute__((aligned(16))) unsigned char lds[];
#endif
    const int wave0 = __builtin_amdgcn_readfirstlane((int)threadIdx.x >> 6);
    if (args.ph_lo == 0) gen_fold_matrix(args.ws, (int)blockIdx.x, (int)gridDim.x, (int)threadIdx.x);
#ifdef CPU_EMU
    if (args.ph_lo == 0) emu_grid_sync();
#else
    if (args.ph_hi - args.ph_lo > 1) { cooperative_groups::this_grid().sync(); }
    for (int u = threadIdx.x; u < (LDS_BYTES - LDS_MISC) / 4; u += 512) ((LAS unsigned*)(lds + LDS_MISC))[u] = 0u;
    __syncthreads();
    XcdBarrier bar = xcd_barrier_post((unsigned*)(args.ws + WS_CTL) + 4096, (volatile LAS unsigned*)(lds + LDS_MISC) + 8);
#endif
#ifndef PROBE_DUP
#define PROBE_DUP -1
#endif
#ifndef PROBE_DRY
#define PROBE_DRY 0
#endif
#define PHASE(k) if (args.ph_lo <= (k) && (k) < args.ph_hi) { if ((k) == PROBE_DUP) { run_phase<k, PROBE_DRY>(args, lds, wave0); GRID_BAR(); } run_phase<k>(args, lds, wave0); if ((k) + 1 < args.ph_hi) GRID_BAR(); }
    PHASE(0) PHASE(1) PHASE(2) PHASE(3) PHASE(4) PHASE(5) PHASE(6) PHASE(7) PHASE(8) PHASE(9) PHASE(10) PHASE(11) PHASE(12)
    PHASE(13) PHASE(14) PHASE(15) PHASE(16) PHASE(17) PHASE(18) PHASE(19) PHASE(20) PHASE(21) PHASE(22)
    static_assert(NPHASE == 23, "phase list");
#undef PHASE
}

#ifndef CPU_EMU
}
extern "C" void kernel_launch(void* const* d_in, const int* in_sizes, int n_in, void* d_out, int out_size, void* d_ws, size_t ws_size, hipStream_t stream) {
    using namespace mk;
    static int grid = 0;
    if (grid == 0) {
        int dev = 0, cus = 0, per_cu = 0;
        if (n_in != 19 || ws_size < WS_END || out_size != ML * D) { fprintf(stderr, "kernel_launch: unexpected sizes n_in %d ws %zu (need %zu) out %d\n", n_in, ws_size, (size_t)WS_END, out_size); grid = -1; return; }
        if (hipGetDevice(&dev) != hipSuccess || hipDeviceGetAttribute(&cus, hipDeviceAttributeMultiprocessorCount, dev) != hipSuccess) { grid = -1; return; }
        if (hipFuncSetAttribute((const void*)mk_fwd, hipFuncAttributeMaxDynamicSharedMemorySize, LDS_BYTES) != hipSuccess) { fprintf(stderr, "kernel_launch: hipFuncSetAttribute failed\n"); grid = -1; return; }
        if (hipOccupancyMaxActiveBlocksPerMultiprocessor(&per_cu, (const void*)mk_fwd, 512, LDS_BYTES) != hipSuccess || per_cu < 1) { fprintf(stderr, "kernel_launch: occupancy query says %d\n", per_cu); (void)hipGetLastError(); grid = -1; return; }
        grid = cus;
    }
    if (grid < 0) return;
    (void)hipMemsetAsync((char*)d_ws + WS_CTL, 0, CTL_BYTES, stream);
    KArgs a{};
    for (int i = 0; i < 19; ++i) a.in[i] = (const float*)d_in[i];
    a.out = (float*)d_out; a.ws = (unsigned char*)d_ws; a.ph_lo = 0; a.ph_hi = NPHASE;
    void* kargs[] = {&a};
    hipError_t e = hipLaunchCooperativeKernel((const void*)mk_fwd, dim3(grid), dim3(512), kargs, LDS_BYTES, stream);
    if (e != hipSuccess) fprintf(stderr, "kernel_launch: cooperative launch failed: %s (grid %d)\n", hipGetErrorString(e), grid);
}
#else
}
#endif
```
